# Optimizing an MI355X kernel written in HIP

```python
import math
import jax, jax.numpy as jnp
from jax import lax
import numpy as np

D_MODEL = 2048
BATCH = 1
SEQ = 8192
DEPTH = 4

HEAD_DIM = 128
RET_HEADS = D_MODEL // 256
RET_V_HEAD_DIM = 2 * HEAD_DIM
RET_QK = RET_HEADS * HEAD_DIM
RET_V = RET_HEADS * RET_V_HEAD_DIM
DIFF_HEADS = D_MODEL // 256
DIFF_QK = 2 * DIFF_HEADS * HEAD_DIM
DIFF_V = DIFF_HEADS * 2 * HEAD_DIM
D_FF = 4 * D_MODEL
RET_CHUNK = 128
Q_BLOCK = 128
ROPE_THETA = 10000.0
NORM_EPS = 1e-6
GN_EPS = 1e-5
SPLITS = (RET_QK, RET_QK, RET_V, RET_V, DIFF_QK, DIFF_QK, DIFF_V, D_MODEL, D_MODEL)
IN_COLS = sum(SPLITS)

kernel_name = "hybrid_retention_diffattn_encoder"


def rms_norm(x, w):
    xf = x.astype(jnp.float32)
    y = xf * lax.rsqrt(jnp.mean(xf * xf, axis=-1, keepdims=True) + NORM_EPS)
    return (y * w.astype(jnp.float32)).astype(x.dtype)


def head_group_norm(x, w):
    xf = x.astype(jnp.float32)
    mu = jnp.mean(xf, axis=-1, keepdims=True)
    var = jnp.mean(jnp.square(xf - mu), axis=-1, keepdims=True)
    return (xf - mu) * lax.rsqrt(var + GN_EPS) * w.astype(jnp.float32)


def rope_tables(L):
    inv = 1.0 / (ROPE_THETA ** (jnp.arange(0, HEAD_DIM, 2, dtype=jnp.float32) / HEAD_DIM))
    ang = jnp.arange(L, dtype=jnp.float32)[:, None] * inv[None, :]
    ang = jnp.concatenate([ang, ang], axis=-1)
    return jnp.cos(ang), jnp.sin(ang)


def apply_rope(x, cos, sin):
    half = x.shape[-1] // 2
    x1, x2 = x[..., :half], x[..., half:]
    rot = jnp.concatenate([-x2, x1], axis=-1)
    return (x * cos + rot * sin).astype(x.dtype)


def retention_direction(q, k, v, log_g):
    q = q.astype(jnp.float32); k = k.astype(jnp.float32); v = v.astype(jnp.float32)
    B, H, L, dk = q.shape
    dv = v.shape[-1]
    C = RET_CHUNK
    N = L // C
    q = q.reshape(B, H, N, C, dk)
    k = k.reshape(B, H, N, C, dk)
    v = v.reshape(B, H, N, C, dv)
    i = jnp.arange(C, dtype=jnp.float32)
    diff = i[:, None] - i[None, :]
    causal_in_chunk = diff >= 0
    intra_decay = jnp.where(causal_in_chunk[None],
                            jnp.exp(jnp.where(causal_in_chunk, diff, 0.0)[None] * log_g[:, None, None]),
                            0.0)
    s = jnp.einsum('bhncd,bhnmd->bhncm', q, k) * intra_decay[None, :, None]
    intra = jnp.einsum('bhncm,bhnme->bhnce', s, v)
    k_w = k * jnp.exp((C - 1 - i)[None, :] * log_g[:, None])[None, :, None, :, None]
    kv = jnp.einsum('bhncd,bhnce->nbhde', k_w, v)
    chunk_decay = jnp.exp(C * log_g)[None, :, None, None]

    def step(state, kv_n):
        return state * chunk_decay + kv_n, state

    _, state_prev = lax.scan(step, jnp.zeros(kv.shape[1:], jnp.float32), kv)
    q_w = q * jnp.exp((i + 1)[None, :] * log_g[:, None])[None, :, None, :, None]
    cross = jnp.einsum('bhncd,nbhde->bhnce', q_w, state_prev)
    return (intra + cross).reshape(B, H, L, dv)


def bidirectional_retention(q, k, v, logit_fwd, logit_bwd):
    lg_f = jax.nn.log_sigmoid(logit_fwd.astype(jnp.float32))
    lg_b = jax.nn.log_sigmoid(logit_bwd.astype(jnp.float32))
    fwd = retention_direction(q, k, v, lg_f)
    bwd = jnp.flip(retention_direction(jnp.flip(q, 2), jnp.flip(k, 2), jnp.flip(v, 2), lg_b), 2)
    return fwd + bwd


def differential_attention(q, k, v, lam):
    B, H, _, L, d = q.shape
    nb = L // Q_BLOCK
    qb = q.reshape(B, H, 2, nb, Q_BLOCK, d).transpose(3, 0, 1, 2, 4, 5)
    scale = d ** -0.5

    def one_block(q_blk):
        s = jnp.einsum('bhtqd,bhtkd->bhtqk', q_blk, k).astype(jnp.float32) * scale
        p = jax.nn.softmax(s, axis=-1)
        a = (p[:, :, 0] - lam * p[:, :, 1]).astype(v.dtype)
        return jnp.einsum('bhqk,bhke->bhqe', a, v)

    o = lax.map(one_block, qb)
    return o.transpose(1, 2, 0, 3, 4).reshape(B, H, L, v.shape[-1])


def setup_inputs(seed: int = 0) -> dict:
    key = jax.random.key(seed)
    ks = jax.random.split(key, 20)

    def dense(k, shape):
        return jax.random.normal(k, shape, jnp.float32) * (shape[-2] ** -0.5)

    def gain(k, shape):
        return 1.0 + 0.02 * jax.random.normal(k, shape, jnp.float32)

    base_logit = jnp.log(2.0 ** (5.0 + jnp.arange(RET_HEADS, dtype=jnp.float32)) - 1.0)
    return {
        "x": jax.random.normal(ks[0], (BATCH, SEQ, D_MODEL), jnp.float32),
        "norm_mix_w": gain(ks[1], (DEPTH, D_MODEL)),
        "w_in": dense(ks[2], (DEPTH, D_MODEL, IN_COLS)),
        "ret_decay_fwd": base_logit[None] + 0.1 * jax.random.normal(ks[3], (DEPTH, RET_HEADS), jnp.float32),
        "ret_decay_bwd": base_logit[None] + 0.1 * jax.random.normal(ks[4], (DEPTH, RET_HEADS), jnp.float32),
        "ret_gn_w": gain(ks[5], (DEPTH, RET_V)),
        "w_ret_out": dense(ks[6], (DEPTH, RET_V, D_MODEL)),
        "q_norm_w": gain(ks[7], (DEPTH, HEAD_DIM)),
        "k_norm_w": gain(ks[8], (DEPTH, HEAD_DIM)),
        "diff_lambda": 0.1 * jax.random.normal(ks[9], (DEPTH, 4, HEAD_DIM), jnp.float32),
        "diff_subln_w": gain(ks[10], (DEPTH, 2 * HEAD_DIM)),
        "w_diff_out": dense(ks[11], (DEPTH, DIFF_V, D_MODEL)),
        "w_out": dense(ks[12], (DEPTH, D_MODEL, D_MODEL)),
        "norm_mlp_w": gain(ks[13], (DEPTH, D_MODEL)),
        "w_mlp_in": dense(ks[14], (DEPTH, D_MODEL, D_FF)),
        "w_mlp_out": dense(ks[15], (DEPTH, D_FF, D_MODEL)),
    }


def reference(x, norm_mix_w, w_in, ret_decay_fwd, ret_decay_bwd, ret_gn_w, w_ret_out,
              q_norm_w, k_norm_w, diff_lambda, diff_subln_w, w_diff_out, w_out,
              norm_mlp_w, w_mlp_in, w_mlp_out):
    B, L, _ = x.shape
    cos, sin = rope_tables(L)
    split_idx = np.cumsum(SPLITS)[:-1].tolist()
    for l in range(DEPTH):
        h = rms_norm(x, norm_mix_w[l])
        proj = jnp.einsum('bld,de->ble', h, w_in[l])
        rq, rk, rv, rg, dq, dk, dv, gr, gd = jnp.split(proj, split_idx, axis=-1)

        rq = apply_rope(rq.reshape(B, L, RET_HEADS, HEAD_DIM).transpose(0, 2, 1, 3), cos, sin)
        rk = apply_rope(rk.reshape(B, L, RET_HEADS, HEAD_DIM).transpose(0, 2, 1, 3), cos, sin) * (HEAD_DIM ** -0.5)
        rv = rv.reshape(B, L, RET_HEADS, RET_V_HEAD_DIM).transpose(0, 2, 1, 3)
        ret = bidirectional_retention(rq, rk, rv, ret_decay_fwd[l], ret_decay_bwd[l])
        ret = head_group_norm(ret.transpose(0, 2, 1, 3),
                              ret_gn_w[l].reshape(RET_HEADS, RET_V_HEAD_DIM)).reshape(B, L, RET_V).astype(x.dtype)
        y_ret = jnp.einsum('ble,ed->bld', jax.nn.silu(rg) * ret, w_ret_out[l])

        dq = dq.reshape(B, L, DIFF_HEADS, 2, HEAD_DIM).transpose(0, 2, 3, 1, 4)
        dk = dk.reshape(B, L, DIFF_HEADS, 2, HEAD_DIM).transpose(0, 2, 3, 1, 4)
        dq = apply_rope(rms_norm(dq, q_norm_w[l]), cos, sin)
        dk = apply_rope(rms_norm(dk, k_norm_w[l]), cos, sin)
        dv = dv.reshape(B, L, DIFF_HEADS, 2 * HEAD_DIM).transpose(0, 2, 1, 3)
        lambda_init = 0.8 - 0.6 * math.exp(-0.3 * l)
        lp = diff_lambda[l].astype(jnp.float32)
        lam = jnp.exp(jnp.sum(lp[0] * lp[1])) - jnp.exp(jnp.sum(lp[2] * lp[3])) + lambda_init
        o = differential_attention(dq, dk, dv, lam)
        o = rms_norm(o, diff_subln_w[l]) * (1.0 - lambda_init)
        y_diff = jnp.einsum('ble,ed->bld', o.transpose(0, 2, 1, 3).reshape(B, L, DIFF_V), w_diff_out[l])

        merged = jax.nn.sigmoid(gr) * y_ret + jax.nn.sigmoid(gd) * y_diff
        x = x + jnp.einsum('bld,de->ble', merged, w_out[l])

        h = rms_norm(x, norm_mlp_w[l])
        u = jnp.square(jax.nn.relu(jnp.einsum('bld,df->blf', h, w_mlp_in[l])))
        x = x + jnp.einsum('blf,fd->bld', u, w_mlp_out[l])
    return x
```

```cpp
#include <hip/hip_runtime.h>
#include <cstdio>
#include <cstdint>
#include <cmath>

#ifndef MK_ONE_LAUNCH
#define MK_ONE_LAUNCH 1
#endif

constexpr int L = 8192, DM = 2048, NLAYER = 4, INC = 16384, DFF = 8192, HD = 128, NH = 8, DV2 = 256, CH = 128, NCH = L / CH;
constexpr float NORM_EPS = 1e-6f, GN_EPS = 1e-5f;
constexpr int NWAVES = 8;
namespace pg8 {
#define PG8_LAS __attribute__((address_space(3)))
typedef unsigned short bf16_t;
typedef short bf16x8 __attribute__((ext_vector_type(8)));
typedef float f32x4 __attribute__((ext_vector_type(4)));
typedef unsigned u32x4 __attribute__((ext_vector_type(4)));
constexpr int BM = 256, BK = 64, HALF = 128, HTB = HALF * BK * 2  , STAGE_BYTES = 8 * HTB, NXCD = 8, WGM = 4;

__host__ __device__ __forceinline__ int lds_byte(int r, int c) { const int st = (r >> 4) * 2 + (c >> 5), rr = r & 15, cc = c & 31, ob = rr * 64 + cc * 2; return st * 1024 + (ob ^ (((ob >> 9) & 1) << 5)); }
__host__ __device__ __forceinline__ void stage_rc(int b, int& R, int& C) { const int st = b / 1024, sb = b % 1024, swz = sb ^ (((sb >> 9) & 1) << 5); R = (st >> 1) * 16 + swz / 64; C = (st & 1) * 32 + (swz % 64) / 2; }
__host__ __device__ __forceinline__ int perm32(int rho) { const int n = rho >> 4, i = rho & 15; return 8 * (i >> 2) + 4 * n + (i & 3); }

struct Unit { int pm, pn; };
struct Gemm { const bf16_t* A; const bf16_t* Bt; int M, N, K; };

struct StaticOrder {
    int nM, nN, nwg, G, c;
    __host__ __device__ void init(int M, int N, int G_, int c_) { nM = M / BM; nN = N / BM; nwg = nM * nN; G = G_; c = c_; }
    __host__ __device__ bool next(int i, Unit& u) const {
        const long L = (long)i * G + c; if (L >= nwg) return false;
        int wgid = (int)L; { const int q = nwg / NXCD, r = nwg % NXCD, xcd = wgid % NXCD, off = wgid / NXCD; wgid = (xcd < r ? xcd * (q + 1) : r * (q + 1) + (xcd - r) * q) + off; }
        const int nig = WGM * nN, gid = wgid / nig, fm = gid * WGM, gsz = (nM - fm) < WGM ? (nM - fm) : WGM;
        u.pm = fm + ((wgid % nig) % gsz); u.pn = (wgid % nig) / gsz; return true;
    }
    __device__ __forceinline__ void a_ready(const Unit&) const {}
    __device__ __forceinline__ void done(const Unit&) const {}
};
template <class Epi, class Sched, bool ALIGN_EPI = false, bool SP2 = false>
__device__ __forceinline__ void gemm_phase(PG8_LAS unsigned char* lds, const Gemm g, const Sched& S, const Epi& E, const int wid_in  ) {
    int lane_; asm volatile("v_mbcnt_lo_u32_b32 %0, -1, 0\n\tv_mbcnt_hi_u32_b32 %0, -1, %0" : "=v"(lane_)); int wid_ = wid_in; asm volatile("" : "+s"(wid_)); const int wid = wid_ & 7, tid = wid * 64 + (lane_ & 63), lane = tid & 63, wr = wid >> 2, wc = wid & 3, fr = lane & 15, fq = lane >> 4;
    const int K = g.K, nt = K / BK;
    unsigned voffA[2], voffB[2];
#pragma unroll
    for (int i = 0; i < 2; ++i) { int R, C; stage_rc(tid * 16 + i * 8192, R, C); const int Rb = Epi::PERM ? ((R & ~31) + perm32(R & 31)) : R;
        voffA[i] = (unsigned)(R * K + C) * 2u; voffB[i] = (unsigned)(Rb * K + C) * 2u; }
    const size_t kstep = (size_t)(BK * 2);
    const size_t hstep = (size_t)HALF * K * 2;
    const size_t tstep = 2 * hstep;
    const unsigned ldsw = (unsigned)wid * 1024u;
    const int aoff = lds_byte(wr * 64 + fr, fq * 8), boff = lds_byte(wc * 32 + fr, fq * 8);
#define PG8_SA(b, h) (((b) * 2 + (h)) * HTB)
#define PG8_SB(b, h) ((4 + (b) * 2 + (h)) * HTB)
#define PG8_STAGE(bufoff, gbase, voff) do { _Pragma("unroll") for (int _i = 0; _i < 2; ++_i) \
        __builtin_amdgcn_global_load_lds((const unsigned*)((const char*)(gbase) + (voff)[_i]), (PG8_LAS unsigned*)(lds + (bufoff) + ldsw + _i * 8192), 16, 0, 0); } while (0)
#define PG8_LDA(dst, b, h) do { _Pragma("unroll") for (int m = 0; m < 4; ++m) _Pragma("unroll") for (int k = 0; k < 2; ++k) dst[m][k] = *(const PG8_LAS bf16x8*)(lds + PG8_SA(b, h) + aoff + m * 2048 + k * 1024); } while (0)
#define PG8_LDB(dst, b, h) do { _Pragma("unroll") for (int n = 0; n < 2; ++n) _Pragma("unroll") for (int k = 0; k < 2; ++k) dst[n][k] = *(const PG8_LAS bf16x8*)(lds + PG8_SB(b, h) + boff + n * 2048 + k * 1024); } while (0)
#define PG8_MMA(ai, bj, At, Bt) do { __builtin_amdgcn_s_setprio(1); _Pragma("unroll") for (int m = 0; m < 4; ++m) _Pragma("unroll") for (int n = 0; n < 2; ++n) _Pragma("unroll") for (int k = 0; k < 2; ++k) \
        acc[ai][bj][m][n] = __builtin_amdgcn_mfma_f32_16x16x32_bf16(Bt[n][k], At[m][k], acc[ai][bj][m][n], 0, 0, 0); __builtin_amdgcn_s_setprio(0); } while (0)
#define PG8_WAIT_V(n) asm volatile("s_waitcnt vmcnt(" #n ")" ::: "memory")
#define PG8_WAIT_L(n) asm volatile("s_waitcnt lgkmcnt(" #n ")" ::: "memory")
#define PG8_BAR __builtin_amdgcn_s_barrier()
#define PG8_SCHED __builtin_amdgcn_sched_barrier(0)
    Unit cur, nxt; int ui = 0;
    if (!S.next(0, cur)) return;
    f32x4 acc[2][2][4][2];
#pragma unroll
    for (int a = 0; a < 2; ++a)
#pragma unroll
        for (int b = 0; b < 2; ++b)
#pragma unroll
            for (int m = 0; m < 4; ++m)
#pragma unroll
                for (int n = 0; n < 2; ++n) acc[a][b][m][n] = (f32x4){0.f, 0.f, 0.f, 0.f};
    bf16x8 At[4][2], B0[2][2], B1[2][2];
    const char* cA = (const char*)g.A + (size_t)cur.pm * tstep; const char* cB = (const char*)g.Bt + (size_t)cur.pn * tstep;
    S.a_ready(cur);
    if constexpr (SP2) {
        PG8_STAGE(PG8_SB(0, 0), cB, voffB); PG8_STAGE(PG8_SB(0, 1), cB + hstep, voffB); PG8_STAGE(PG8_SA(0, 0), cA, voffA); PG8_STAGE(PG8_SA(0, 1), cA + hstep, voffA);
        if (wr == 1) PG8_BAR;
        PG8_WAIT_V(2); PG8_BAR;
        PG8_STAGE(PG8_SB(1, 0), cB + kstep, voffB); PG8_STAGE(PG8_SA(1, 0), cA + kstep, voffA); PG8_STAGE(PG8_SB(1, 1), cB + hstep + kstep, voffB);
        PG8_WAIT_V(6); PG8_BAR;
    } else {
        PG8_STAGE(PG8_SB(0, 0), cB, voffB); PG8_STAGE(PG8_SA(0, 0), cA, voffA); PG8_STAGE(PG8_SB(0, 1), cB + hstep, voffB); PG8_STAGE(PG8_SA(0, 1), cA + hstep, voffA);
        if (wr == 1) PG8_BAR;
        PG8_WAIT_V(4); PG8_BAR;
        PG8_STAGE(PG8_SB(1, 0), cB + kstep, voffB); PG8_STAGE(PG8_SA(1, 0), cA + kstep, voffA); PG8_STAGE(PG8_SB(1, 1), cB + hstep + kstep, voffB);
        PG8_WAIT_V(6); PG8_BAR;
    }
    for (;;) {
        const bool has_next = S.next(ui + 1, nxt);
        const char* nA = has_next ? (const char*)g.A + (size_t)nxt.pm * tstep : cA; const char* nB = has_next ? (const char*)g.Bt + (size_t)nxt.pn * tstep : cB;
        for (int t = 0; t < nt; t += 2) {
            const bool last = (t == nt - 2);
            const char* a1 = cA + (size_t)(t + 1) * kstep;
            const char* a2 = last ? nA : cA + (size_t)(t + 2) * kstep; const char* b2 = last ? nB : cB + (size_t)(t + 2) * kstep;
            const char* a3 = a2 + kstep; const char* b3 = b2 + kstep;
            if (last && has_next) S.a_ready(nxt);
            if constexpr (SP2) {
            PG8_LDB(B0, 0, 0); PG8_LDB(B1, 0, 1); PG8_SCHED; PG8_LDA(At, 0, 0); PG8_STAGE(PG8_SA(1, 1), a1 + hstep, voffA);
            PG8_WAIT_V(8); PG8_WAIT_L(0); PG8_BAR; PG8_MMA(0, 0, At, B0); PG8_MMA(0, 1, At, B1); PG8_BAR; PG8_SCHED;
            PG8_LDA(At, 0, 1); PG8_STAGE(PG8_SB(0, 0), b2, voffB); PG8_STAGE(PG8_SB(0, 1), b2 + hstep, voffB); PG8_STAGE(PG8_SA(0, 0), a2, voffA);
            PG8_WAIT_V(8); PG8_WAIT_L(0); PG8_BAR; PG8_MMA(1, 0, At, B0); PG8_MMA(1, 1, At, B1); PG8_BAR; PG8_SCHED;
            PG8_LDB(B0, 1, 0); PG8_LDB(B1, 1, 1); PG8_SCHED; PG8_LDA(At, 1, 0); PG8_STAGE(PG8_SA(0, 1), a2 + hstep, voffA);
            PG8_WAIT_V(8); PG8_WAIT_L(0); PG8_BAR; PG8_MMA(0, 0, At, B0); PG8_MMA(0, 1, At, B1); PG8_BAR; PG8_SCHED;
            PG8_LDA(At, 1, 1); PG8_STAGE(PG8_SB(1, 0), b3, voffB); PG8_STAGE(PG8_SB(1, 1), b3 + hstep, voffB); PG8_STAGE(PG8_SA(1, 0), a3, voffA);
            PG8_WAIT_V(8); PG8_WAIT_L(0); PG8_BAR; PG8_MMA(1, 0, At, B0); PG8_MMA(1, 1, At, B1); PG8_BAR; PG8_SCHED;
            } else {
            PG8_LDB(B0, 0, 0); PG8_SCHED; PG8_LDA(At, 0, 0); PG8_STAGE(PG8_SA(1, 1), a1 + hstep, voffA);
            PG8_WAIT_L(8); PG8_BAR; PG8_WAIT_L(0); PG8_MMA(0, 0, At, B0); PG8_BAR; PG8_SCHED;
            PG8_LDB(B1, 0, 1); PG8_STAGE(PG8_SB(0, 0), b2, voffB);
            PG8_BAR; PG8_WAIT_L(0); PG8_MMA(0, 1, At, B1); PG8_BAR;
            PG8_LDA(At, 0, 1); PG8_STAGE(PG8_SA(0, 0), a2, voffA);
            PG8_BAR; PG8_WAIT_L(0); PG8_MMA(1, 0, At, B0); PG8_BAR; PG8_SCHED;
            PG8_STAGE(PG8_SB(0, 1), b2 + hstep, voffB);
            PG8_WAIT_V(6); PG8_BAR; PG8_MMA(1, 1, At, B1); PG8_BAR;
            PG8_LDB(B0, 1, 0); PG8_SCHED; PG8_LDA(At, 1, 0); PG8_STAGE(PG8_SA(0, 1), a2 + hstep, voffA);
            PG8_WAIT_L(8); PG8_BAR; PG8_WAIT_L(0); PG8_MMA(0, 0, At, B0); PG8_BAR; PG8_SCHED;
            PG8_LDB(B1, 1, 1); PG8_STAGE(PG8_SB(1, 0), b3, voffB);
            PG8_BAR; PG8_WAIT_L(0); PG8_MMA(0, 1, At, B1); PG8_BAR;
            PG8_LDA(At, 1, 1); PG8_STAGE(PG8_SA(1, 0), a3, voffA);
            PG8_BAR; PG8_WAIT_L(0); PG8_MMA(1, 0, At, B0); PG8_BAR; PG8_SCHED;
            PG8_STAGE(PG8_SB(1, 1), b3 + hstep, voffB);
            PG8_WAIT_V(6); PG8_BAR; PG8_MMA(1, 1, At, B1); PG8_BAR;
            }
        }
        if constexpr (ALIGN_EPI) { if (wr == 0) PG8_BAR; }
        if constexpr (!Epi::AFTER_DRAIN) { E(acc, cur, wr, wc, fr, fq); S.done(cur); }
        if (!has_next) break;
#pragma unroll
        for (int a = 0; a < 2; ++a)
#pragma unroll
            for (int b = 0; b < 2; ++b)
#pragma unroll
                for (int m = 0; m < 4; ++m)
#pragma unroll
                    for (int n = 0; n < 2; ++n) acc[a][b][m][n] = (f32x4){0.f, 0.f, 0.f, 0.f};
        cur = nxt; cA = nA; cB = nB; ++ui;
        if constexpr (ALIGN_EPI) { if (wr == 1) PG8_BAR; }
    }
    PG8_WAIT_V(0);
    if constexpr (!ALIGN_EPI) { if (wr == 0) PG8_BAR; }
    PG8_BAR;
    if constexpr (Epi::AFTER_DRAIN) { E.fused(acc, cur, wr, wc, fr, fq, lds, wid, lane); S.done(cur); }
#undef PG8_SA
#undef PG8_SB
#undef PG8_STAGE
#undef PG8_LDA
#undef PG8_LDB
#undef PG8_MMA
#undef PG8_WAIT_V
#undef PG8_WAIT_L
#undef PG8_BAR
#undef PG8_SCHED
}
}

constexpr size_t MiB = 1u << 20;
constexpr size_t WS_CTL = 0, CTL_ZERO_BYTES = 1 * MiB;
constexpr size_t WS_CONST = 2 * MiB;
constexpr size_t WS_ROPE = 4 * MiB;
constexpr size_t WS_W = 16 * MiB, W_LAYER = 152 * MiB;
constexpr size_t W_IN = 0, W_RO = 64 * MiB, W_DO = 72 * MiB, W_OUT = 80 * MiB, W_1 = 88 * MiB, W_2 = 120 * MiB;
constexpr size_t WS_XB = 640 * MiB, WS_QR = 672 * MiB, WS_KR = 688 * MiB, WS_VR = 704 * MiB, WS_GR = 736 * MiB, WS_DQ = 768 * MiB, WS_DK = 800 * MiB,
                 WS_DV = 832 * MiB, WS_SGR = 864 * MiB, WS_SGD = 896 * MiB, WS_KVF = 928 * MiB, WS_KVB = 992 * MiB, WS_STF = 1056 * MiB, WS_STB = 1088 * MiB,
                 WS_URET = 1120 * MiB, WS_ODIFF = 1152 * MiB, WS_T1 = 1184 * MiB, WS_MERGED = 1248 * MiB, WS_UMLP = 1280 * MiB, WS_ATT = 1408 * MiB, WS_SSQP = 1472 * MiB, WS_END = 1488 * MiB;
constexpr int CW_TMO = 0, CW_BAR = 4096;

constexpr int LDS_BYTES = 155648;
constexpr int MISC_OFF = 153600;

#define GAS __attribute__((address_space(1)))
#define LAS __attribute__((address_space(3)))
typedef unsigned short bf16_t;
typedef unsigned v4u __attribute__((ext_vector_type(4)));
typedef unsigned v2u __attribute__((ext_vector_type(2)));
typedef float f32x4 __attribute__((ext_vector_type(4)));
typedef float f32x16 __attribute__((ext_vector_type(16)));
typedef short bf16x8 __attribute__((ext_vector_type(8)));
typedef short s16x4 __attribute__((ext_vector_type(4)));
typedef GAS unsigned gu32;
#define RLX_AGENT __ATOMIC_RELAXED, __HIP_MEMORY_SCOPE_AGENT
#define LDS_WAIT() asm volatile("s_waitcnt lgkmcnt(0)" ::: "memory")
#define VM_WAIT() asm volatile("s_waitcnt vmcnt(0)" ::: "memory")
#define SBAR() __builtin_amdgcn_sched_barrier(0)
__device__ __forceinline__ unsigned f2bf(float f) { unsigned u = __builtin_bit_cast(unsigned, f); return (u + 0x7fffu + ((u >> 16) & 1u)) >> 16; }
__device__ __forceinline__ unsigned pk2(float lo, float hi) { return f2bf(lo) | (f2bf(hi) << 16); }
__device__ __forceinline__ float bf2f(unsigned short b) { return __builtin_bit_cast(float, (unsigned)b << 16); }
__device__ __forceinline__ float bflo(unsigned w) { return __builtin_bit_cast(float, w << 16); }
__device__ __forceinline__ float bfhi(unsigned w) { return __builtin_bit_cast(float, w & 0xffff0000u); }
__device__ __forceinline__ unsigned cvtpk(float lo, float hi) { unsigned r; asm volatile("v_cvt_pk_bf16_f32 %0, %1, %2" : "=v"(r) : "v"(lo), "v"(hi)); return r; }
__device__ __forceinline__ int crow(int r, int hi) { return (r & 3) + 8 * (r >> 2) + 4 * hi; }
__device__ __forceinline__ int lane_id() { int l; asm volatile("v_mbcnt_lo_u32_b32 %0, -1, 0\n\tv_mbcnt_hi_u32_b32 %0, -1, %0" : "=v"(l)); return l; }
template <int M> __device__ __forceinline__ float sw_xor(float v) { return __builtin_bit_cast(float, __builtin_amdgcn_ds_swizzle(__builtin_bit_cast(int, v), (M << 10) | 0x1f)); }
__device__ __forceinline__ void swap32(float& a, float& b) { asm volatile("s_nop 1\n\tv_permlane32_swap_b32 %0, %1\n\ts_nop 1" : "+v"(a), "+v"(b)); }
__device__ __forceinline__ float add_xor32(float v) { float a = v, b = v; swap32(a, b); return a + b; }
__device__ __forceinline__ float max_xor32(float v) { float a = v, b = v; swap32(a, b); return fmaxf(a, b); }
__device__ __forceinline__ float sum16(float v) { v += sw_xor<1>(v); v += sw_xor<2>(v); v += sw_xor<4>(v); v += sw_xor<8>(v); return v; }
__device__ __forceinline__ float sum32(float v) { v = sum16(v); v += sw_xor<16>(v); return v; }
__device__ __forceinline__ int opaque(int x) { asm volatile("" : "+v"(x)); return x & 511; }
__device__ __forceinline__ float wave_sum(float v) { return add_xor32(sum32(v)); }
__device__ __forceinline__ float wave_max(float v) { v = fmaxf(v, sw_xor<1>(v)); v = fmaxf(v, sw_xor<2>(v)); v = fmaxf(v, sw_xor<4>(v)); v = fmaxf(v, sw_xor<8>(v)); v = fmaxf(v, sw_xor<16>(v)); return max_xor32(v); }
__device__ __forceinline__ float fsigmoid(float x) { return __builtin_amdgcn_rcpf(1.f + __expf(-x)); }

#define XB_TMO      128
#define XB_XCNT(j)  (256  + 64 * (j))
#define XB_XSUB(j)  (1280 + 64 * (j))
#define XB_XGEN(j)  (2304 + 64 * (j))
#define XB_TOP      3328
#define XB_TOPGEN   3392
#define XCD_BAR_WORDS 3456
#define XB_SPIN_CAP (1u << 18)
__device__ __forceinline__ unsigned xb_ld(unsigned* p)              { return __hip_atomic_load(p, __ATOMIC_RELAXED, __HIP_MEMORY_SCOPE_AGENT); }
__device__ __forceinline__ unsigned xb_add(unsigned* p, unsigned v) { return __hip_atomic_fetch_add(p, v, __ATOMIC_RELAXED, __HIP_MEMORY_SCOPE_AGENT); }
__device__ __forceinline__ unsigned xb_xcc_id() { return (unsigned)__builtin_amdgcn_s_getreg((3 << 11) | 20) & 0xFu; }
#define XB_SPIN(cond, bar) do { unsigned _sp = 0; while (cond) { __builtin_amdgcn_s_sleep(1); \
    if ((++_sp & 255u) == 0u) { if (xb_ld(&(bar)[XB_TMO])) break; if (_sp > XB_SPIN_CAP) { atomicAdd(&(bar)[XB_TMO], 1u); break; } } } } while (0)
struct XcdBarrier { unsigned* bar; unsigned x; volatile LAS unsigned* st; };
__device__ __forceinline__ XcdBarrier xcd_barrier_post(unsigned* bar, volatile LAS unsigned* st, bool leader) {
    XcdBarrier b; b.bar = bar; b.x = xb_xcc_id(); b.st = st;
    if (leader) (void)xb_add(&bar[XB_XCNT(b.x)], 1u);
    return b;
}
__device__ __forceinline__ void xcd_barrier_complete(unsigned* bar, unsigned x, unsigned& nloc, unsigned& nx) {
    const unsigned G = gridDim.x * gridDim.y * gridDim.z;
    unsigned sum, cnt, mine, sp = 0u;
    for (;;) {
        sum = 0u; cnt = 0u; mine = 0u;
#pragma unroll
        for (unsigned j = 0; j < 16; ++j) { const unsigned c = xb_ld(&bar[XB_XCNT(j)]); sum += c; cnt += (c > 0u) ? 1u : 0u; mine = (j == x) ? c : mine; }
        if (sum == G) break;
        __builtin_amdgcn_s_sleep(1);
        if ((++sp & 255u) == 0u) { if (xb_ld(&bar[XB_TMO])) break; if (sp > XB_SPIN_CAP) { atomicAdd(&bar[XB_TMO], 1u); break; } }
    }
    nloc = mine > 0u ? mine : 1u; nx = cnt > 0u ? cnt : 1u;
}
__device__ __forceinline__ void xcd_barrier(const XcdBarrier& b, bool leader  ) {
    asm volatile("s_waitcnt vmcnt(0)" ::: "memory");
    __syncthreads();
    if (leader) {
        unsigned* bar = b.bar;
        __builtin_amdgcn_s_waitcnt(0);
        unsigned nloc = b.st[0], nx = b.st[1];
        if (nloc == 0u) { xcd_barrier_complete(bar, b.x, nloc, nx); b.st[0] = nloc; b.st[1] = nx; }
        const unsigned old = xb_add(&bar[XB_XSUB(b.x)], 1u);
        const unsigned gen = old / nloc;
        if (old + 1u == (gen + 1u) * nloc) {
            __builtin_amdgcn_fence(__ATOMIC_RELEASE, "agent");
            asm volatile("s_waitcnt vmcnt(0)" ::: "memory");
            const unsigned og = xb_add(&bar[XB_TOP], 1u);
            const unsigned tg = og / nx;
            if (og + 1u == (tg + 1u) * nx) xb_add(&bar[XB_TOPGEN], 1u);
            else XB_SPIN(xb_ld(&bar[XB_TOPGEN]) == tg, bar);
            __builtin_amdgcn_fence(__ATOMIC_ACQUIRE, "agent");
            xb_add(&bar[XB_XGEN(b.x)], 1u);
            asm volatile("s_waitcnt vmcnt(0)" ::: "memory");
        } else {
            XB_SPIN(xb_ld(&bar[XB_XGEN(b.x)]) == gen, bar);
            __builtin_amdgcn_fence(__ATOMIC_ACQUIRE, "agent");
            asm volatile("s_waitcnt vmcnt(0)" ::: "memory");
        }
    }
    __syncthreads();
}

struct Args {
    const float* in[16]; float* out; unsigned char* ws;
    float inv[64];
    float om_lam_init[4];
    float lam_init[4];
    int ph_lo, ph_hi, pad0, pad1;
};
struct Frame {
    LAS unsigned char* lds;
    unsigned char* ws;
    int tid, lane, wave, G;
};
#define WSP(T, off) ((T*)(F.ws + (off)))

using pg8::Unit;
__device__ __forceinline__ void rows_rs(const float* ssqp, int row0, int fq, float (&rs)[2][4]) {
    f32x4 pa[2][4], pb[2][4];
#pragma unroll
    for (int ai = 0; ai < 2; ++ai)
#pragma unroll
        for (int m = 0; m < 4; ++m) { const f32x4* p = (const f32x4*)(ssqp + (size_t)(row0 + ai * 128 + m * 16) * 32) + 2 * fq; pa[ai][m] = p[0]; pb[ai][m] = p[1]; }
#pragma unroll
    for (int ai = 0; ai < 2; ++ai)
#pragma unroll
        for (int m = 0; m < 4; ++m) { const f32x4 q = pa[ai][m] + pb[ai][m]; float t = (q[0] + q[1]) + (q[2] + q[3]); t += sw_xor<16>(t); t = add_xor32(t);
            rs[ai][m] = __builtin_amdgcn_rsqf(t * (1.0f / DM) + NORM_EPS); }
}
struct EpiInProj {
    static constexpr bool PERM = true, AFTER_DRAIN = false;
    const float* ssqp; const float* cs; unsigned char* ws; LAS float* xch; const float* qw; const float* kw;
    __device__ __forceinline__ void operator()(const f32x4 (&acc)[2][2][4][2], const Unit& u, int wr, int wc, int fr_, int fq_) const {
        (void)fr_; (void)fq_; const int ln_ = lane_id() & 63, fr = ln_ & 15, fq = ln_ >> 4;
        const int pn = u.pn, seg = pn >> 2, id = seg < 2 ? seg : (seg >> 1) + 1;
        const size_t boff = WS_QR + (size_t)(id < 2 ? 16 * id : 32 * (id - 1)) * MiB;
        const int ld = id < 2 ? 1024 : 2048, cb = (pn - (id < 2 ? 4 * id : 8 * (id - 1))) * 256;
        const int op = id < 2 ? 1 : (id == 3 ? 2 : (id >= 7 ? 3 : ((id == 4 || id == 5) ? 4 : 0)));
        const float sc = id == 1 ? 0.08838834764831845f : 1.0f;
        bf16_t* base = (bf16_t*)(ws + boff);
        const int row0 = u.pm * 256 + wr * 64 + fr, col0 = cb + wc * 32 + 8 * fq, j0 = 16 * wc + 4 * fq;
        float rs[2][4]; rows_rs(ssqp, row0, fq, rs);
        if (op == 1) {
            f32x4 ca[2][4], cb4[2][4];
#pragma unroll
            for (int ai = 0; ai < 2; ++ai)
#pragma unroll
                for (int m = 0; m < 4; ++m) { const f32x4* cp = (const f32x4*)(cs + ((size_t)(row0 + ai * 128 + m * 16) * 64 + j0) * 2); ca[ai][m] = cp[0]; cb4[ai][m] = cp[1]; }
#pragma unroll
            for (int ai = 0; ai < 2; ++ai)
#pragma unroll
                for (int m = 0; m < 4; ++m) {
                    bf16_t* rowp = base + (size_t)(row0 + ai * 128 + m * 16) * ld + col0; const f32x4 c0 = ca[ai][m], c1 = cb4[ai][m]; const float r = rs[ai][m] * sc;
#pragma unroll
                    for (int bj = 0; bj < 2; ++bj) {
                        const f32x4 v0 = acc[ai][bj][m][0] * r, v1 = acc[ai][bj][m][1] * r;
                        v4u w; w.x = cvtpk(v0[0] * c0[0] - v0[1] * c0[1], v0[1] * c0[0] + v0[0] * c0[1]); w.y = cvtpk(v0[2] * c0[2] - v0[3] * c0[3], v0[3] * c0[2] + v0[2] * c0[3]);
                        w.z = cvtpk(v1[0] * c1[0] - v1[1] * c1[1], v1[1] * c1[0] + v1[0] * c1[1]); w.w = cvtpk(v1[2] * c1[2] - v1[3] * c1[3], v1[3] * c1[2] + v1[2] * c1[3]);
                        *(v4u*)(rowp + bj * 128) = w;
                    }
                }
        } else if (op == 4) {
            LAS float* xp = xch + wr * 1024;
#pragma unroll
            for (int ai = 0; ai < 2; ++ai)
#pragma unroll
                for (int m = 0; m < 4; ++m)
#pragma unroll
                    for (int bj = 0; bj < 2; ++bj) { const f32x4 v0 = acc[ai][bj][m][0], v1 = acc[ai][bj][m][1];
                        float ss = (v0[0] * v0[0] + v0[1] * v0[1]) + (v0[2] * v0[2] + v0[3] * v0[3]) + (v1[0] * v1[0] + v1[1] * v1[1]) + (v1[2] * v1[2] + v1[3] * v1[3]);
                        ss += sw_xor<16>(ss); ss = add_xor32(ss);
                        if (fq == 0) xp[((ai * 4 + m) * 16 + fr) * 8 + bj * 4 + wc] = ss; }
            asm volatile("s_waitcnt lgkmcnt(0)" ::: "memory"); __builtin_amdgcn_s_barrier(); asm volatile("" ::: "memory");
            const float* gw = (id == 4) ? qw : kw;
            const f32x4 w1 = *(const f32x4*)(gw + j0), w2 = *(const f32x4*)(gw + 64 + j0);
#pragma unroll
            for (int ai = 0; ai < 2; ++ai) {
                f32x4 ca[4], cb4[4];
#pragma unroll
                for (int m = 0; m < 4; ++m) { const f32x4* cp = (const f32x4*)(cs + ((size_t)(row0 + ai * 128 + m * 16) * 64 + j0) * 2); ca[m] = cp[0]; cb4[m] = cp[1]; }
#pragma unroll
                for (int m = 0; m < 4; ++m) {
                    bf16_t* rowp = base + (size_t)(row0 + ai * 128 + m * 16) * ld + col0; const f32x4 c0 = ca[m], c1 = cb4[m]; const float r = rs[ai][m];
#pragma unroll
                    for (int bj = 0; bj < 2; ++bj) {
                        const f32x4 t = *(const LAS f32x4*)(xp + ((ai * 4 + m) * 16 + fr) * 8 + bj * 4);
                        const float cn = r * __builtin_amdgcn_rsqf(((t[0] + t[1]) + (t[2] + t[3])) * (r * r) * (1.0f / HD) + NORM_EPS);
                        const f32x4 v0 = acc[ai][bj][m][0] * cn, v1 = acc[ai][bj][m][1] * cn;
                        const float a0 = v0[0] * w1[0], b0 = v0[1] * w2[0], a1 = v0[2] * w1[1], b1 = v0[3] * w2[1], a2 = v1[0] * w1[2], b2 = v1[1] * w2[2], a3 = v1[2] * w1[3], b3 = v1[3] * w2[3];
                        v4u w; w.x = cvtpk(a0 * c0[0] - b0 * c0[1], b0 * c0[0] + a0 * c0[1]); w.y = cvtpk(a1 * c0[2] - b1 * c0[3], b1 * c0[2] + a1 * c0[3]);
                        w.z = cvtpk(a2 * c1[0] - b2 * c1[1], b2 * c1[0] + a2 * c1[1]); w.w = cvtpk(a3 * c1[2] - b3 * c1[3], b3 * c1[2] + a3 * c1[3]);
                        *(v4u*)(rowp + bj * 128) = w;
                    }
                }
                asm volatile("" ::: "memory");
            }
        } else {
#pragma unroll
            for (int ai = 0; ai < 2; ++ai)
#pragma unroll
                for (int m = 0; m < 4; ++m) {
                    bf16_t* rowp = base + (size_t)(row0 + ai * 128 + m * 16) * ld + col0; const float r = rs[ai][m];
#pragma unroll
                    for (int bj = 0; bj < 2; ++bj) {
                        f32x4 v0 = acc[ai][bj][m][0] * r, v1 = acc[ai][bj][m][1] * r;
                        if (op == 2) {
#pragma unroll
                            for (int e = 0; e < 4; ++e) { v0[e] = v0[e] * fsigmoid(v0[e]); v1[e] = v1[e] * fsigmoid(v1[e]); }
                        } else if (op == 3) {
#pragma unroll
                            for (int e = 0; e < 4; ++e) { v0[e] = fsigmoid(v0[e]); v1[e] = fsigmoid(v1[e]); }
                        }
                        v4u w; w.x = cvtpk(v0[0], v0[1]); w.y = cvtpk(v0[2], v0[3]); w.z = cvtpk(v1[0], v1[1]); w.w = cvtpk(v1[2], v1[3]);
                        *(v4u*)(rowp + bj * 128) = w;
                    }
                }
        }
    }
};
struct EpiGateA {
    static constexpr bool PERM = true, AFTER_DRAIN = false;
    const bf16_t* sg; float* T1;
    __device__ __forceinline__ void operator()(const f32x4 (&acc)[2][2][4][2], const Unit& u, int wr, int wc, int fr_, int fq_) const {
        (void)fr_; (void)fq_; const int ln_ = lane_id() & 63, fr = ln_ & 15, fq = ln_ >> 4;
        const int row0 = u.pm * 256 + wr * 64 + fr, col0 = u.pn * 256 + wc * 32 + 8 * fq;
        v4u g[2][4][2];
#pragma unroll
        for (int ai = 0; ai < 2; ++ai)
#pragma unroll
            for (int m = 0; m < 4; ++m)
#pragma unroll
                for (int bj = 0; bj < 2; ++bj) g[ai][m][bj] = *(const v4u*)(sg + (size_t)(row0 + ai * 128 + m * 16) * DM + col0 + bj * 128);
#pragma unroll
        for (int ai = 0; ai < 2; ++ai)
#pragma unroll
            for (int m = 0; m < 4; ++m)
#pragma unroll
                for (int bj = 0; bj < 2; ++bj) {
                    const size_t off = (size_t)(row0 + ai * 128 + m * 16) * DM + col0 + bj * 128; const v4u q = g[ai][m][bj];
                    f32x4 v0 = acc[ai][bj][m][0], v1 = acc[ai][bj][m][1];
                    v0[0] *= bflo(q.x); v0[1] *= bfhi(q.x); v0[2] *= bflo(q.y); v0[3] *= bfhi(q.y);
                    v1[0] *= bflo(q.z); v1[1] *= bfhi(q.z); v1[2] *= bflo(q.w); v1[3] *= bfhi(q.w);
                    *(f32x4*)(T1 + off) = v0; *(f32x4*)(T1 + off + 4) = v1;
                }
    }
};
struct EpiGateB {
    static constexpr bool PERM = true, AFTER_DRAIN = false;
    const bf16_t* sg; const float* T1; bf16_t* out;
    __device__ __forceinline__ void operator()(const f32x4 (&acc)[2][2][4][2], const Unit& u, int wr, int wc, int fr_, int fq_) const {
        (void)fr_; (void)fq_; const int ln_ = lane_id() & 63, fr = ln_ & 15, fq = ln_ >> 4;
        const int row0 = u.pm * 256 + wr * 64 + fr, col0 = u.pn * 256 + wc * 32 + 8 * fq;
#pragma unroll
        for (int ai = 0; ai < 2; ++ai) {
            v4u g[4][2]; f32x4 t0[4][2], t1[4][2];
#pragma unroll
            for (int m = 0; m < 4; ++m)
#pragma unroll
                for (int bj = 0; bj < 2; ++bj) { const size_t off = (size_t)(row0 + ai * 128 + m * 16) * DM + col0 + bj * 128;
                    g[m][bj] = *(const v4u*)(sg + off); t0[m][bj] = *(const f32x4*)(T1 + off); t1[m][bj] = *(const f32x4*)(T1 + off + 4); }
#pragma unroll
            for (int m = 0; m < 4; ++m)
#pragma unroll
                for (int bj = 0; bj < 2; ++bj) { const size_t off = (size_t)(row0 + ai * 128 + m * 16) * DM + col0 + bj * 128; const v4u q = g[m][bj]; const f32x4 a0 = t0[m][bj], a1 = t1[m][bj];
                    f32x4 v0 = acc[ai][bj][m][0], v1 = acc[ai][bj][m][1];
                    v0[0] = a0[0] + v0[0] * bflo(q.x); v0[1] = a0[1] + v0[1] * bfhi(q.x); v0[2] = a0[2] + v0[2] * bflo(q.y); v0[3] = a0[3] + v0[3] * bfhi(q.y);
                    v1[0] = a1[0] + v1[0] * bflo(q.z); v1[1] = a1[1] + v1[1] * bfhi(q.z); v1[2] = a1[2] + v1[2] * bflo(q.w); v1[3] = a1[3] + v1[3] * bfhi(q.w);
                    v4u w; w.x = cvtpk(v0[0], v0[1]); w.y = cvtpk(v0[2], v0[3]); w.z = cvtpk(v1[0], v1[1]); w.w = cvtpk(v1[2], v1[3]);
                    *(v4u*)(out + off) = w; }
            asm volatile("" ::: "memory");
        }
    }
};
struct EpiResid {
    static constexpr bool PERM = true, AFTER_DRAIN = false;
    const float* xin; float* xout; bf16_t* xb; float* ssqp_out;
    __device__ __forceinline__ void operator()(const f32x4 (&acc)[2][2][4][2], const Unit& u, int wr, int wc, int fr_, int fq_) const {
        (void)fr_; (void)fq_; const int ln_ = lane_id() & 63, fr = ln_ & 15, fq = ln_ >> 4;
        const int row0 = u.pm * 256 + wr * 64 + fr, col0 = u.pn * 256 + wc * 32 + 8 * fq;
#pragma unroll
        for (int ai = 0; ai < 2; ++ai) {
            f32x4 x0[4][2], x1[4][2];
#pragma unroll
            for (int m = 0; m < 4; ++m)
#pragma unroll
                for (int bj = 0; bj < 2; ++bj) { const size_t off = (size_t)(row0 + ai * 128 + m * 16) * DM + col0 + bj * 128; x0[m][bj] = *(const f32x4*)(xin + off); x1[m][bj] = *(const f32x4*)(xin + off + 4); }
#pragma unroll
            for (int m = 0; m < 4; ++m) {
                const int row = row0 + ai * 128 + m * 16; float ps = 0.f;
#pragma unroll
                for (int bj = 0; bj < 2; ++bj) {
                    const size_t off = (size_t)row * DM + col0 + bj * 128;
                    const f32x4 v0 = x0[m][bj] + acc[ai][bj][m][0], v1 = x1[m][bj] + acc[ai][bj][m][1];
                    *(f32x4*)(xout + off) = v0; *(f32x4*)(xout + off + 4) = v1;
                    ps += (v0[0] * v0[0] + v0[1] * v0[1]) + (v0[2] * v0[2] + v0[3] * v0[3]) + (v1[0] * v1[0] + v1[1] * v1[1]) + (v1[2] * v1[2] + v1[3] * v1[3]);
                    v4u w; w.x = cvtpk(v0[0], v0[1]); w.y = cvtpk(v0[2], v0[3]); w.z = cvtpk(v1[0], v1[1]); w.w = cvtpk(v1[2], v1[3]);
                    *(v4u*)(xb + off) = w;
                }
                ps += sw_xor<16>(ps); ps = add_xor32(ps);
                if (fq == 0) ssqp_out[(size_t)row * 32 + u.pn * 4 + wc] = ps;
            }
            asm volatile("" ::: "memory");
        }
    }
};
struct EpiMlpIn {
    static constexpr bool PERM = true, AFTER_DRAIN = false;
    const float* ssqp; bf16_t* out;
    __device__ __forceinline__ void operator()(const f32x4 (&acc)[2][2][4][2], const Unit& u, int wr, int wc, int fr_, int fq_) const {
        (void)fr_; (void)fq_; const int ln_ = lane_id() & 63, fr = ln_ & 15, fq = ln_ >> 4;
        const int row0 = u.pm * 256 + wr * 64 + fr, col0 = u.pn * 256 + wc * 32 + 8 * fq;
        float rs[2][4]; rows_rs(ssqp, row0, fq, rs);
#pragma unroll
        for (int ai = 0; ai < 2; ++ai)
#pragma unroll
            for (int m = 0; m < 4; ++m) {
                const int row = row0 + ai * 128 + m * 16; const float r = rs[ai][m];
#pragma unroll
                for (int bj = 0; bj < 2; ++bj) {
                    f32x4 v0 = acc[ai][bj][m][0] * r, v1 = acc[ai][bj][m][1] * r;
#pragma unroll
                    for (int e = 0; e < 4; ++e) { const float a = fmaxf(v0[e], 0.f), b = fmaxf(v1[e], 0.f); v0[e] = a * a; v1[e] = b * b; }
                    v4u w; w.x = cvtpk(v0[0], v0[1]); w.y = cvtpk(v0[2], v0[3]); w.z = cvtpk(v1[0], v1[1]); w.w = cvtpk(v1[2], v1[3]);
                    *(v4u*)(out + (size_t)row * DFF + col0 + bj * 128) = w;
                }
            }
    }
};

__device__ __forceinline__ float log2_gamma_calc(const float* logit) { const float x = *logit; return -log1pf(expf(-x)) * 1.4426950408889634f; }
__device__ __forceinline__ int srccol_win(int n) {
    const bool p = (n < 2048) || (n >= 6144 && n < 10240);
    return p ? ((n & ~127) + ((n & 127) >> 1) + ((n & 1) << 6)) : n;
}
constexpr int CP = 68;
struct ConvItem { const float* W; bf16_t* WT; const float* rscale; int K, N, rmask, k0, n0; float mulc; bool perm; };
__device__ __forceinline__ void conv_load(const ConvItem& d, f32x4 (&v)[16], int lane) {
    const int s4 = (lane & 15) * 4;
    const int col = d.perm ? ((d.n0 & ~127) + ((d.n0 & 127) >> 1) + (s4 & 31) + ((s4 >> 5) << 6)) : d.n0 + s4;
#pragma unroll
    for (int i = 0; i < 16; ++i) { const int kk = 4 * i + (lane >> 4); v[i] = __builtin_nontemporal_load((const f32x4*)(d.W + (size_t)(d.k0 + kk) * d.N + col)); }
}
__device__ __forceinline__ void conv_store(const ConvItem& d, const f32x4 (&v)[16], LAS float* scr, int lane) {
    const int s4 = (lane & 15) * 4;
#pragma unroll
    for (int i = 0; i < 16; ++i) { const int kk = 4 * i + (lane >> 4); const float sc = d.rscale ? d.rscale[(d.k0 + kk) & d.rmask] * d.mulc : 1.0f;
        *(LAS f32x4*)(scr + kk * CP + s4) = v[i] * sc; }
    LDS_WAIT(); asm volatile("" ::: "memory");
    const int c = lane & 7;
#pragma unroll
    for (int j = 0; j < 8; ++j) { const int r = (lane >> 3) + 8 * j, sidx = d.perm ? ((r >> 1) + 32 * (r & 1)) : r; const LAS float* q = scr + (8 * c) * CP + sidx;
        v4u o; o.x = pk2(q[0 * CP], q[1 * CP]); o.y = pk2(q[2 * CP], q[3 * CP]); o.z = pk2(q[4 * CP], q[5 * CP]); o.w = pk2(q[6 * CP], q[7 * CP]);
        *(v4u*)(d.WT + (size_t)(d.n0 + r) * d.K + d.k0 + 8 * c) = o; }
    LDS_WAIT(); asm volatile("" ::: "memory");
}
__device__ __forceinline__ void sincos_f32angle(float angf, float& c, float& s) {
    const double a = (double)angf;
    const double kq = __builtin_rint(a * 0.63661977236758134308);
    const double r = (a - kq * 1.5707963267948966192) - kq * 6.123233995736766e-17;
    const double r2 = r * r;
    double sp = -7.647163731819816e-13; sp = sp * r2 + 1.6059043836821613e-10; sp = sp * r2 - 2.5052108385441720e-08; sp = sp * r2 + 2.7557319223985893e-06;
    sp = sp * r2 - 1.9841269841269841e-04; sp = sp * r2 + 8.3333333333333333e-03; sp = sp * r2 - 1.6666666666666666e-01; const double sn = r + r * r2 * sp;
    double cp = 4.7794773323873853e-14; cp = cp * r2 - 1.1470745597729725e-11; cp = cp * r2 + 2.0876756987868099e-09; cp = cp * r2 - 2.7557319223985888e-07;
    cp = cp * r2 + 2.4801587301587302e-05; cp = cp * r2 - 1.3888888888888889e-03; cp = cp * r2 + 4.1666666666666664e-02; cp = cp * r2 - 0.5; const double cn = 1.0 + r2 * cp;
    const int q = ((int)kq) & 3;
    const double cc = (q == 0) ? cn : (q == 1) ? -sn : (q == 2) ? -cn : sn;
    const double ss = (q == 0) ? sn : (q == 1) ? cn : (q == 2) ? -sn : -cn;
    c = (float)cc; s = (float)ss;
}
#define CONV_DESC(d, it_) ConvItem d; { int r = (it_); \
    if (r < I_2) { d.W = w2s; d.K = DFF; d.N = DM; d.WT = (bf16_t*)(wl + W_2); d.rscale = nullptr; d.rmask = 0; d.mulc = 1.0f; d.perm = false; } \
    else if ((r -= I_2) < I_1) { d.W = w1s; d.K = DM; d.N = DFF; d.WT = (bf16_t*)(wl + W_1); d.rscale = g_mlp; d.rmask = DM - 1; d.mulc = 1.0f; d.perm = false; } \
    else if ((r -= I_1) < I_SQ) { d.W = wos; d.K = DM; d.N = DM; d.WT = (bf16_t*)(wl + W_OUT); d.rscale = nullptr; d.rmask = 0; d.mulc = 1.0f; d.perm = false; } \
    else if ((r -= I_SQ) < I_SQ) { d.W = wds; d.K = DM; d.N = DM; d.WT = (bf16_t*)(wl + W_DO); d.rscale = g_sub; d.rmask = DV2 - 1; d.mulc = oml; d.perm = false; } \
    else if ((r -= I_SQ) < I_SQ) { d.W = wrs; d.K = DM; d.N = DM; d.WT = (bf16_t*)(wl + W_RO); d.rscale = g_gn; d.rmask = DM - 1; d.mulc = 1.0f; d.perm = false; } \
    else { r -= I_SQ; d.W = wis; d.K = DM; d.N = INC; d.WT = (bf16_t*)(wl + W_IN); d.rscale = g_mix; d.rmask = DM - 1; d.mulc = 1.0f; d.perm = true; } \
    const int nblk = d.N / 64; d.k0 = 64 * (r / nblk); d.n0 = 64 * (r % nblk); \
    d.perm = d.perm && (d.n0 < 2048 || (d.n0 >= 6144 && d.n0 < 10240)); }
__device__ __forceinline__ void conv_layer(Frame& F, const Args& A, int l) {
    LAS float* scr = (LAS float*)(F.lds + F.wave * 17408);
    const int gw = blockIdx.x * NWAVES + F.wave, NGW = F.G * NWAVES, ln = lane_id() & 63;
    constexpr int I_IN = (DM / 64) * (INC / 64), I_SQ = (DM / 64) * (DM / 64), I_1 = (DM / 64) * (DFF / 64), I_2 = (DFF / 64) * (DM / 64);
    constexpr int I_LAYER = I_IN + 3 * I_SQ + I_1 + I_2;
    unsigned char* wl = F.ws + WS_W + (size_t)l * W_LAYER;
    const float* w2s = A.in[15] + (size_t)l * DFF * DM; const float* w1s = A.in[14] + (size_t)l * DM * DFF; const float* wos = A.in[12] + (size_t)l * DM * DM;
    const float* wds = A.in[11] + (size_t)l * DM * DM; const float* wrs = A.in[6] + (size_t)l * DM * DM; const float* wis = A.in[2] + (size_t)l * DM * INC;
    const float* g_mlp = A.in[13] + l * DM; const float* g_sub = A.in[10] + l * DV2; const float* g_gn = A.in[5] + l * DM; const float* g_mix = A.in[1] + l * DM; const float oml = A.om_lam_init[l];
    f32x4 va[16], vb[16]; int i0 = gw, i1 = gw + NGW;
    if (i0 < I_LAYER) { CONV_DESC(d, i0); conv_load(d, va, ln); }
    while (i0 < I_LAYER) {
        if (i1 < I_LAYER) { CONV_DESC(d, i1); conv_load(d, vb, ln); }
        { CONV_DESC(d, i0); conv_store(d, va, scr, ln); }
        i0 = i1 + NGW;
        if (i1 >= I_LAYER) break;
        if (i0 < I_LAYER) { CONV_DESC(d, i0); conv_load(d, va, ln); }
        { CONV_DESC(d, i1); conv_store(d, vb, scr, ln); }
        i1 = i0 + NGW;
    }
}
__device__ __forceinline__ void p0_prologue(Frame& F, const Args& A) {
    const int gw = blockIdx.x * NWAVES + F.wave, NGW = F.G * NWAVES;
    conv_layer(F, A, 0);
    {
        const float* x = A.in[0]; bf16_t* xb = WSP(bf16_t, WS_XB); float* ssqp = WSP(float, WS_SSQP);
        for (int m = gw; m < L; m += NGW) {
            const f32x4* xr = (const f32x4*)(x + (size_t)m * DM) + F.lane; float s = 0.f;
            unsigned long long* o8 = (unsigned long long*)(xb + (size_t)m * DM) + F.lane;
#pragma unroll
            for (int j = 0; j < 8; ++j) { const f32x4 v = xr[64 * j]; s += (v[0] * v[0] + v[1] * v[1]) + (v[2] * v[2] + v[3] * v[3]);
                o8[64 * j] = (unsigned long long)pk2(v[0], v[1]) | ((unsigned long long)pk2(v[2], v[3]) << 32); }
            s = wave_sum(s);
            if (F.lane < 32) ssqp[(size_t)m * 32 + F.lane] = F.lane == 0 ? s : 0.f;
        }
    }
    {
        float* cs = WSP(float, WS_ROPE);
        for (int p = gw; p < L; p += NGW) { const float ang = (float)p * A.inv[F.lane]; float c, s; sincos_f32angle(ang, c, s);
            *(float2*)(cs + ((size_t)p * 64 + F.lane) * 2) = make_float2(c, s); }
    }
    if (blockIdx.x == 0 && F.wave < NLAYER) {
        const int l = F.wave; const float* lp = A.in[9] + l * 4 * HD; const float* qw = A.in[7] + l * HD; const float* kw = A.in[8] + l * HD;
        float s01 = 0.f, s23 = 0.f, mq = 0.f, mk = 0.f;
        for (int i = F.lane; i < HD; i += 64) { s01 += lp[i] * lp[HD + i]; s23 += lp[2 * HD + i] * lp[3 * HD + i]; mq = fmaxf(mq, fabsf(qw[i])); mk = fmaxf(mk, fabsf(kw[i])); }
        s01 = wave_sum(s01); s23 = wave_sum(s23);
        mq = wave_max(mq); mk = wave_max(mk);
        if (F.lane < 2 * NH) { const int dir = F.lane >> 3, h = F.lane & 7; WSP(float, WS_CONST)[8 + (l * 2 + dir) * NH + h] = log2_gamma_calc((dir ? A.in[4] : A.in[3]) + l * NH + h); }
        if (F.lane == 0) { float* cst = WSP(float, WS_CONST); cst[l] = expf(s01) - expf(s23) + A.lam_init[l];
            cst[4 + l] = 128.0f * mq * mk * 0.12751743082459868f; }
    }
}

constexpr int TP = 136;
#define LG2G(F, layer, dir, h) (WSP(float, WS_CONST)[8 + ((layer) * 2 + (dir)) * NH + (h)])
__device__ __forceinline__ void phase_r1(Frame& F, const Args& A, int layer) {
    LAS bf16_t* KtF = (LAS bf16_t*)F.lds; LAS bf16_t* KtB = KtF + 128 * TP; LAS bf16_t* Vt = KtB + 128 * TP;
    const int wid = F.wave;
    const bf16_t* KR = WSP(bf16_t, WS_KR); const bf16_t* VR = WSP(bf16_t, WS_VR);
    for (int u = blockIdx.x; u < NCH * NH; u += F.G) {
        const int cc = u >> 3, h = u & 7;
        const float lgf = LG2G(F, layer, 0, h), lgb = LG2G(F, layer, 1, h);
        const int tid_o = (F.wave * 64 + (lane_id() & 63)), r32 = tid_o & 31, hi = (tid_o >> 5) & 1;
        __syncthreads();
#pragma unroll
        for (int i = 0; i < 4; ++i) { const int q = tid_o + 512 * i, pos = q & 127, d0 = (q >> 7) * 8;
            const v4u v = *(const v4u*)(KR + (size_t)(cc * CH + pos) * 1024 + h * HD + d0);
            const float wf = __builtin_amdgcn_exp2f((float)(127 - pos) * lgf), wb = __builtin_amdgcn_exp2f((float)pos * lgb);
            const float e[8] = {bflo(v.x), bfhi(v.x), bflo(v.y), bfhi(v.y), bflo(v.z), bfhi(v.z), bflo(v.w), bfhi(v.w)};
#pragma unroll
            for (int k = 0; k < 8; ++k) { KtF[(d0 + k) * TP + pos] = (bf16_t)f2bf(e[k] * wf); KtB[(d0 + k) * TP + pos] = (bf16_t)f2bf(e[k] * wb); } }
#pragma unroll
        for (int i = 0; i < 8; ++i) { const int q = tid_o + 512 * i, pos = q & 127, d0 = (q >> 7) * 8;
            const v4u v = *(const v4u*)(VR + (size_t)(cc * CH + pos) * DM + h * DV2 + d0);
            const unsigned w[4] = {v.x, v.y, v.z, v.w};
#pragma unroll
            for (int k = 0; k < 4; ++k) { Vt[(d0 + 2 * k) * TP + pos] = (bf16_t)(w[k] & 0xffffu); Vt[(d0 + 2 * k + 1) * TP + pos] = (bf16_t)(w[k] >> 16); } }
        __syncthreads();
#pragma unroll
        for (int dir = 0; dir < 2; ++dir) {
            const LAS bf16_t* Kt = dir ? KtB : KtF;
            f32x16 acc[4];
#pragma unroll
            for (int n = 0; n < 4; ++n)
#pragma unroll
                for (int r = 0; r < 16; ++r) acc[n][r] = 0.f;
#pragma unroll 2
            for (int ks = 0; ks < 8; ++ks) {
                const bf16x8 a = *(const LAS bf16x8*)(Vt + (32 * wid + r32) * TP + ks * 16 + hi * 8);
#pragma unroll
                for (int n = 0; n < 4; ++n) { const bf16x8 b = *(const LAS bf16x8*)(Kt + (32 * n + r32) * TP + ks * 16 + hi * 8);
                    acc[n] = __builtin_amdgcn_mfma_f32_32x32x16_bf16(a, b, acc[n], 0, 0, 0); }
            }
            bf16_t* out = (dir ? WSP(bf16_t, WS_KVB) : WSP(bf16_t, WS_KVF)) + ((size_t)(cc * NH + h) * DV2 + 32 * wid) * HD;
#pragma unroll
            for (int n = 0; n < 4; ++n)
#pragma unroll
                for (int r = 0; r < 16; ++r) out[crow(r, hi) * HD + 32 * n + r32] = (bf16_t)f2bf(acc[n][r]);
        }
    }
}
__device__ __forceinline__ void phase_r2(Frame& F, const Args& A, int layer) {
    constexpr int PER_DIR = NH * DV2 * HD / 4;
    constexpr size_t CSTR = (size_t)NH * DV2 * HD;
    for (int gid = blockIdx.x * 512 + (F.wave * 64 + (lane_id() & 63)); gid < 2 * PER_DIR; gid += F.G * 512) {
        const int dir = gid >= PER_DIR, e4 = gid - dir * PER_DIR, h = e4 / (DV2 * HD / 4);
        const float lg = LG2G(F, layer, dir, h), Gm = __builtin_amdgcn_exp2f(128.0f * lg);
        const bf16_t* kv = (dir ? WSP(bf16_t, WS_KVB) : WSP(bf16_t, WS_KVF)) + (size_t)e4 * 4;
        bf16_t* st = (dir ? WSP(bf16_t, WS_STB) : WSP(bf16_t, WS_STF)) + (size_t)e4 * 4;
        f32x4 s = {0.f, 0.f, 0.f, 0.f};
#pragma unroll 8
        for (int i = 0; i < NCH; ++i) { const int c = dir ? (NCH - 1 - i) : i;
            const v2u vw = *(const v2u*)(kv + (size_t)c * CSTR); const f32x4 v = {bflo(vw.x), bfhi(vw.x), bflo(vw.y), bfhi(vw.y)};
            v2u o; o.x = cvtpk(s[0], s[1]); o.y = cvtpk(s[2], s[3]); *(v2u*)(st + (size_t)c * CSTR) = o;
            s = s * Gm + v; }
    }
}
__device__ __forceinline__ bf16x8 scale_bf8(bf16x8 q, float a) {
    v4u w = __builtin_bit_cast(v4u, q), o;
    o.x = cvtpk(bflo(w.x) * a, bfhi(w.x) * a); o.y = cvtpk(bflo(w.y) * a, bfhi(w.y) * a); o.z = cvtpk(bflo(w.z) * a, bfhi(w.z) * a); o.w = cvtpk(bflo(w.w) * a, bfhi(w.w) * a);
    return __builtin_bit_cast(bf16x8, o);
}
__device__ __forceinline__ void phase_r3(Frame& F, const Args& A, int layer) {
    LAS bf16_t* Ks = (LAS bf16_t*)F.lds; LAS bf16_t* Vt = Ks + 128 * TP;
    const int wid = F.wave;
    const bf16_t* QR = WSP(bf16_t, WS_QR); const bf16_t* KR = WSP(bf16_t, WS_KR); const bf16_t* VR = WSP(bf16_t, WS_VR); const bf16_t* GR = WSP(bf16_t, WS_GR);
    bf16_t* UR = WSP(bf16_t, WS_URET);
    for (int u = blockIdx.x; u < NCH * NH; u += F.G) {
        const int cc = u >> 3, h = u & 7;
        const int tid_o = (F.wave * 64 + (lane_id() & 63)), lane_o = tid_o & 63, c16 = lane_o & 15, g = lane_o >> 4;
        const float lgf = LG2G(F, layer, 0, h), lgb = LG2G(F, layer, 1, h);
        __syncthreads();
#pragma unroll
        for (int i = 0; i < 4; ++i) { const int q = tid_o + 512 * i, row = q >> 4, ch = q & 15;
            *(LAS v4u*)(Ks + row * TP + ch * 8) = *(const v4u*)(KR + (size_t)(cc * CH + row) * 1024 + h * HD + ch * 8); }
#pragma unroll
        for (int i = 0; i < 8; ++i) { const int q = tid_o + 512 * i, pos = q & 127, d0 = (q >> 7) * 8;
            const v4u v = *(const v4u*)(VR + (size_t)(cc * CH + pos) * DM + h * DV2 + d0);
            const unsigned w[4] = {v.x, v.y, v.z, v.w};
#pragma unroll
            for (int k = 0; k < 4; ++k) { Vt[(d0 + 2 * k) * TP + pos] = (bf16_t)(w[k] & 0xffffu); Vt[(d0 + 2 * k + 1) * TP + pos] = (bf16_t)(w[k] >> 16); } }
        __syncthreads();
        const int pos_i = 16 * wid + c16; const size_t gpos = (size_t)cc * CH + pos_i;
        bf16x8 qf[4];
#pragma unroll
        for (int s = 0; s < 4; ++s) qf[s] = *(const bf16x8*)(QR + gpos * 1024 + h * HD + 32 * s + 8 * g);
        f32x4 st[8];
#pragma unroll
        for (int b = 0; b < 8; ++b) { st[b] = (f32x4){0.f, 0.f, 0.f, 0.f};
#pragma unroll
            for (int s = 0; s < 4; ++s) { const bf16x8 a = *(const LAS bf16x8*)(Ks + (16 * b + c16) * TP + 32 * s + 8 * g);
                st[b] = __builtin_amdgcn_mfma_f32_16x16x32_bf16(a, qf[s], st[b], 0, 0, 0); } }
#pragma unroll
        for (int b = 0; b < 8; ++b)
#pragma unroll
            for (int r = 0; r < 4; ++r) { const int d = pos_i - (16 * b + 4 * g + r);
                const float m = d > 0 ? __builtin_amdgcn_exp2f((float)d * lgf) : (d < 0 ? __builtin_amdgcn_exp2f((float)(-d) * lgb) : 2.0f);
                st[b][r] *= m; }
        f32x4 R[16];
#pragma unroll
        for (int n = 0; n < 16; ++n) R[n] = (f32x4){0.f, 0.f, 0.f, 0.f};
#pragma unroll
        for (int s2 = 0; s2 < 4; ++s2) {
            v4u pw; pw.x = cvtpk(st[2 * s2][0], st[2 * s2][1]); pw.y = cvtpk(st[2 * s2][2], st[2 * s2][3]); pw.z = cvtpk(st[2 * s2 + 1][0], st[2 * s2 + 1][1]); pw.w = cvtpk(st[2 * s2 + 1][2], st[2 * s2 + 1][3]);
            const bf16x8 pa = __builtin_bit_cast(bf16x8, pw);
#pragma unroll
            for (int n = 0; n < 16; ++n) {
                const v2u lo = *(const LAS v2u*)(Vt + (16 * n + c16) * TP + 32 * s2 + 4 * g), hi4 = *(const LAS v2u*)(Vt + (16 * n + c16) * TP + 32 * s2 + 16 + 4 * g);
                v4u bw; bw.x = lo.x; bw.y = lo.y; bw.z = hi4.x; bw.w = hi4.y;
                R[n] = __builtin_amdgcn_mfma_f32_16x16x32_bf16(pa, __builtin_bit_cast(bf16x8, bw), R[n], 0, 0, 0);
            }
            asm volatile("" ::: "memory");
        }
#pragma unroll
        for (int dir = 0; dir < 2; ++dir) {
            const float asc = dir ? __builtin_amdgcn_exp2f((float)(CH - pos_i) * lgb) : __builtin_amdgcn_exp2f((float)(pos_i + 1) * lgf);
            const bf16_t* ST = (dir ? WSP(bf16_t, WS_STB) : WSP(bf16_t, WS_STF)) + (size_t)(cc * NH + h) * DV2 * HD;
#pragma unroll
            for (int s = 0; s < 4; ++s) { const bf16x8 qs = scale_bf8(qf[s], asc);
#pragma unroll
                for (int n = 0; n < 16; ++n) { const bf16x8 b = *(const bf16x8*)(ST + (size_t)(16 * n + c16) * HD + 32 * s + 8 * g);
                    R[n] = __builtin_amdgcn_mfma_f32_16x16x32_bf16(qs, b, R[n], 0, 0, 0); }
                asm volatile("" ::: "memory"); }
        }
#pragma unroll
        for (int r = 0; r < 4; ++r) {
            float s = 0.f;
#pragma unroll
            for (int n = 0; n < 16; ++n) s += R[n][r];
            s = sum16(s);
            const float mean = s * (1.0f / DV2); float q = 0.f;
#pragma unroll
            for (int n = 0; n < 16; ++n) { const float d = R[n][r] - mean; q += d * d; }
            q = sum16(q);
            const float rstd = __builtin_amdgcn_rsqf(q * (1.0f / DV2) + GN_EPS);
            int c16o = c16; asm volatile("" : "+v"(c16o) : "v"(rstd));
            const size_t ro = ((size_t)cc * CH + 16 * wid + 4 * g + r) * DM + h * DV2 + (c16o & 15);
            const GAS bf16_t* gp = (const GAS bf16_t*)(GR + ro); GAS bf16_t* up = (GAS bf16_t*)(UR + ro);
#pragma unroll
            for (int n = 0; n < 16; ++n) up[16 * n] = (bf16_t)f2bf((R[n][r] - mean) * rstd * bf2f(gp[16 * n]));
            asm volatile("" ::: "memory");
        }
    }
}

constexpr int AK_BYTES = 16384, AV_BYTES = 32768, AV_OFF = 2 * AK_BYTES, ASCR_OFF = AV_OFF + 3 * AV_BYTES;
#define KSWZ(row, colB) ((row) * 256 + ((colB) ^ (((row) & 15) << 4)))
__device__ __forceinline__ int v_rd_base(int lane) { return ((lane & 3) << 3) | (((lane >> 2) & 3) << 6) | (((lane >> 4) & 1) << 5) | (((lane >> 5) & 1) << 8); }
constexpr int v_rd_off(int d0, int ks, int half) { return d0 * 512 + ks * 8192 + half * 4096; }
template <int OFF> __device__ __forceinline__ s16x4 tr_read(int vb) {
    s16x4 r; asm volatile("ds_read_b64_tr_b16 %0, %1 offset:%2" : "=&v"(r) : "v"(vb), "i"(OFF) : "memory"); return r;
}
struct VFrag { s16x4 l0, h0, l1, h1, l2, h2, l3, h3; };
template <int D0> __device__ __forceinline__ void pv_reads(VFrag& f, int vb) {
    f.l0 = tr_read<v_rd_off(D0, 0, 0)>(vb); f.h0 = tr_read<v_rd_off(D0, 0, 1)>(vb); f.l1 = tr_read<v_rd_off(D0, 1, 0)>(vb); f.h1 = tr_read<v_rd_off(D0, 1, 1)>(vb);
    f.l2 = tr_read<v_rd_off(D0, 2, 0)>(vb); f.h2 = tr_read<v_rd_off(D0, 2, 1)>(vb); f.l3 = tr_read<v_rd_off(D0, 3, 0)>(vb); f.h3 = tr_read<v_rd_off(D0, 3, 1)>(vb);
}
__device__ __forceinline__ void pv_mma(f32x16& od, const VFrag& f, bf16x8 pa0, bf16x8 pa1, bf16x8 pa2, bf16x8 pa3) {
#define PKV(Lx, Hx) (bf16x8){Lx[0], Lx[1], Lx[2], Lx[3], Hx[0], Hx[1], Hx[2], Hx[3]}
    od = __builtin_amdgcn_mfma_f32_32x32x16_bf16(pa0, PKV(f.l0, f.h0), od, 0, 0, 0);
    od = __builtin_amdgcn_mfma_f32_32x32x16_bf16(pa1, PKV(f.l1, f.h1), od, 0, 0, 0);
    od = __builtin_amdgcn_mfma_f32_32x32x16_bf16(pa2, PKV(f.l2, f.h2), od, 0, 0, 0);
    od = __builtin_amdgcn_mfma_f32_32x32x16_bf16(pa3, PKV(f.l3, f.h3), od, 0, 0, 0);
#undef PKV
}
#define PV_WAIT8() do { asm volatile("s_waitcnt lgkmcnt(8)" ::: "memory"); SBAR(); } while (0)
#define PV_WAIT0() do { asm volatile("s_waitcnt lgkmcnt(0)" ::: "memory"); SBAR(); } while (0)
template <class DmaF> __device__ __forceinline__ void pv_tile(f32x16 (&o)[8], int vb, bf16x8 pa0, bf16x8 pa1, bf16x8 pa2, bf16x8 pa3, DmaF dma) {
    VFrag fa, fb;
    pv_reads<0>(fa, vb);
    pv_reads<1>(fb, vb); PV_WAIT8(); pv_mma(o[0], fa, pa0, pa1, pa2, pa3);
    pv_reads<2>(fa, vb); PV_WAIT8(); pv_mma(o[1], fb, pa0, pa1, pa2, pa3);
    dma();
    pv_reads<3>(fb, vb); PV_WAIT8(); pv_mma(o[2], fa, pa0, pa1, pa2, pa3);
    pv_reads<4>(fa, vb); PV_WAIT8(); pv_mma(o[3], fb, pa0, pa1, pa2, pa3);
    pv_reads<5>(fb, vb); PV_WAIT8(); pv_mma(o[4], fa, pa0, pa1, pa2, pa3);
    pv_reads<6>(fa, vb); PV_WAIT8(); pv_mma(o[5], fb, pa0, pa1, pa2, pa3);
    pv_reads<7>(fb, vb); PV_WAIT8(); pv_mma(o[6], fa, pa0, pa1, pa2, pa3);
    PV_WAIT0(); pv_mma(o[7], fb, pa0, pa1, pa2, pa3);
}
__device__ __forceinline__ void phase_attn(Frame& F, const Args& A, int layer) {
    const int lane = (lane_id() & 63), wid = F.wave, r32 = lane & 31, hi = lane >> 5;
    LAS unsigned char* Kl = F.lds; LAS unsigned char* Vl = F.lds + AV_OFF;
    LAS float* wsf = (LAS float*)(F.lds + ASCR_OFF) + wid * 64;
    const float lam = WSP(float, WS_CONST)[layer], Bs = WSP(float, WS_CONST)[4 + layer];
    const bf16_t* DQ = WSP(bf16_t, WS_DQ); const bf16_t* DK = WSP(bf16_t, WS_DK); const bf16_t* DV = WSP(bf16_t, WS_DV); bf16_t* OD = WSP(bf16_t, WS_ODIFF);
    const int vb0 = (int)(uintptr_t)Vl + v_rd_base(lane);
    constexpr int I_IN = (DM / 64) * (INC / 64), I_SQ = (DM / 64) * (DM / 64), I_1 = (DM / 64) * (DFF / 64), I_2 = (DFF / 64) * (DM / 64);
    constexpr int I_LAYER = I_IN + 3 * I_SQ + I_1 + I_2;
    const int cv_n = (F.G == 256 && layer + 1 < NLAYER) ? I_LAYER : 0;
    const int l1 = layer + 1 < NLAYER ? layer + 1 : layer;
    unsigned char* wl = F.ws + WS_W + (size_t)l1 * W_LAYER;
    const float* w2s = A.in[15] + (size_t)l1 * DFF * DM; const float* w1s = A.in[14] + (size_t)l1 * DM * DFF; const float* wos = A.in[12] + (size_t)l1 * DM * DM;
    const float* wds = A.in[11] + (size_t)l1 * DM * DM; const float* wrs = A.in[6] + (size_t)l1 * DM * DM; const float* wis = A.in[2] + (size_t)l1 * DM * INC;
    const float* g_mlp = A.in[13] + l1 * DM; const float* g_sub = A.in[10] + l1 * DV2; const float* g_gn = A.in[5] + l1 * DM; const float* g_mix = A.in[1] + l1 * DM; const float oml = A.om_lam_init[l1];
    LAS unsigned char* cvs = F.lds + ASCR_OFF + 2048 + wid * 2304;
    int cm = 0, ci = 0;
#define ATT_CONV() do { \
    if (cm == 0) { const int it_ = (int)blockIdx.x + ci * 256; if (it_ < cv_n) { CONV_DESC(d, it_); \
        const int lc = lane_id() & 63, s4 = (lc & 15) * 4; \
        const int col = d.perm ? ((d.n0 & ~127) + ((d.n0 & 127) >> 1) + (s4 & 31) + ((s4 >> 5) << 6)) : d.n0 + s4; \
        const float* src = d.W + (size_t)(d.k0 + 8 * wid + (lc >> 4)) * d.N + col; \
        __builtin_amdgcn_global_load_lds((const unsigned*)src, (LAS unsigned*)cvs, 16, 0, 0); \
        __builtin_amdgcn_global_load_lds((const unsigned*)(src + 4 * (size_t)d.N), (LAS unsigned*)(cvs + 1024), 16, 0, 0); \
        if (d.rscale) __builtin_amdgcn_global_load_lds((const unsigned*)(d.rscale + ((d.k0 + 8 * wid + (lc & 7)) & d.rmask)), (LAS unsigned*)(cvs + 2048), 4, 0, 0); } } \
    else if (cm == 1) { const int it_ = (int)blockIdx.x + ci * 256; if (it_ < cv_n) { CONV_DESC(d, it_); \
        const int lc = lane_id() & 63, sidx = d.perm ? ((lc >> 1) + 32 * (lc & 1)) : lc; \
        const LAS float* q = (const LAS float*)cvs + sidx; float e[8]; \
        _Pragma("unroll") for (int i = 0; i < 8; ++i) e[i] = q[64 * i]; \
        if (d.rscale) { const f32x4 sa = *(const LAS f32x4*)(cvs + 2048), sb = *(const LAS f32x4*)(cvs + 2064); \
            _Pragma("unroll") for (int i = 0; i < 4; ++i) { e[i] *= sa[i] * d.mulc; e[4 + i] *= sb[i] * d.mulc; } } \
        v4u o_; o_.x = pk2(e[0], e[1]); o_.y = pk2(e[2], e[3]); o_.z = pk2(e[4], e[5]); o_.w = pk2(e[6], e[7]); \
        *(v4u*)(d.WT + (size_t)(d.n0 + lc) * d.K + d.k0 + 8 * wid) = o_; } } } while (0)
#define ATT_CONV_NEXT() do { cm = cm == 2 ? 0 : cm + 1; ci += cm == 0 ? 1 : 0; } while (0)
    for (int u = blockIdx.x; u < NH * (L / 256); u += F.G) {
        const int h = u & 7, qb = u >> 3;
        const int ld_ = opaque(lane) & 63; unsigned koff[2], voff[4];
#pragma unroll
        for (int i = 0; i < 2; ++i) { const int p = 2 * wid + i, row = 4 * p + (ld_ >> 4), c = (ld_ & 15) ^ (row & 15); koff[i] = (unsigned)(row * DM + c * 8) * 2u; }
#pragma unroll
        for (int i = 0; i < 4; ++i) { const int p = 4 * wid + i, s = 2 * p + (ld_ >> 5), kg = s >> 3, cb = s & 7, rin = (ld_ & 31) >> 2, kk = kg * 8 + rin;
        const int k = (kk & ~0xC) | ((kk & 4) << 1) | ((kk & 8) >> 1), c = cb * 32 + (ld_ & 3) * 8; voff[i] = (unsigned)(k * DM + c) * 2u; }
        float* scratch = WSP(float, WS_ATT) + ((size_t)(u * NWAVES + wid) * 128) * 64 + lane;
#pragma unroll 1
        for (int t = 0; t < 2; ++t) {
            int lq = lane; asm volatile("" : "+v"(lq));
            const bf16_t* Qp = DQ + (size_t)(qb * 256 + wid * 32 + (lq & 31)) * DM + (h * 2 + t) * HD + (lq >> 5) * 8;
            bf16x8 qr[8];
#pragma unroll
            for (int d0 = 0; d0 < 8; ++d0) qr[d0] = *(const bf16x8*)(Qp + d0 * 16);
            const char* Kg = (const char*)(DK + (h * 2 + t) * HD); const char* Vg = (const char*)(DV + h * DV2);
#define ATT_DMA_K(j, b) do { const char* kb_ = Kg + (size_t)(j) * (64 * DM * 2); \
            _Pragma("unroll") for (int i_ = 0; i_ < 2; ++i_) { unsigned ko_ = koff[i_]; asm volatile("" : "+v"(ko_)); __builtin_amdgcn_global_load_lds((const unsigned*)(kb_ + ko_), (LAS unsigned*)(Kl + (b) * AK_BYTES + (2 * wid + i_) * 1024), 16, 0, 0); } } while (0)
#define ATT_DMA_V(j, b) do { const char* vb_ = Vg + (size_t)(j) * (64 * DM * 2); \
            _Pragma("unroll") for (int i_ = 0; i_ < 4; ++i_) { unsigned vo_ = voff[i_]; asm volatile("" : "+v"(vo_)); __builtin_amdgcn_global_load_lds((const unsigned*)(vb_ + vo_), (LAS unsigned*)(Vl + (b) * AV_BYTES + (4 * wid + i_) * 1024), 16, 0, 0); } } while (0)
#define ATT_HSYNC(N) do { asm volatile("s_waitcnt vmcnt(" #N ")" ::: "memory"); asm volatile("s_waitcnt lgkmcnt(0)" ::: "memory"); __builtin_amdgcn_s_barrier(); asm volatile("" ::: "memory"); } while (0)
            constexpr float C2 = 0.12751743082459868f;
#define ATT_QKSM(b, DMA_STMT, CONV_STMT) do { const LAS unsigned char* Ks = Kl + (b) * AK_BYTES; f32x16 p0, p1; \
            _Pragma("unroll") for (int r = 0; r < 16; ++r) { p0[r] = 0.f; p1[r] = 0.f; } \
            __builtin_amdgcn_s_setprio(2); \
            _Pragma("unroll") for (int d0 = 0; d0 < 8; ++d0) { const int cbb = (d0 * 16 + hi * 8) * 2; \
                const bf16x8 b0 = *(const LAS bf16x8*)(Ks + KSWZ(r32, cbb)); const bf16x8 b1 = *(const LAS bf16x8*)(Ks + KSWZ(32 + r32, cbb)); \
                p0 = __builtin_amdgcn_mfma_f32_32x32x16_bf16(b0, qr[d0], p0, 0, 0, 0); p1 = __builtin_amdgcn_mfma_f32_32x32x16_bf16(b1, qr[d0], p1, 0, 0, 0); } \
            __builtin_amdgcn_s_setprio(0); DMA_STMT; CONV_STMT; \
            float ps = 0.f; \
            _Pragma("unroll") for (int r = 0; r < 16; ++r) { p0[r] = __builtin_amdgcn_exp2f(fmaf(p0[r], C2, -Bs)); p1[r] = __builtin_amdgcn_exp2f(fmaf(p1[r], C2, -Bs)); ps += p0[r] + p1[r]; } \
            l_reg += ps; PK4(p0, 0, pa0); PK4(p0, 8, pa1); PK4(p1, 0, pa2); PK4(p1, 8, pa3); } while (0)
#define PK4(P, BASE, OUT) do { unsigned a0 = cvtpk(P[BASE + 0], P[BASE + 1]), a1 = cvtpk(P[BASE + 2], P[BASE + 3]);   \
    unsigned b0_ = cvtpk(P[BASE + 4], P[BASE + 5]), b1_ = cvtpk(P[BASE + 6], P[BASE + 7]);                              \
    auto r0 = __builtin_amdgcn_permlane32_swap(a0, b0_, false, false); auto r1 = __builtin_amdgcn_permlane32_swap(a1, b1_, false, false); \
    v4u w_ = {r0[0], r1[0], r0[1], r1[1]}; OUT = __builtin_bit_cast(bf16x8, w_); } while (0)
#define ATT_PV(b, DMA_STMT) do { const int vb_ = (int)(uintptr_t)Vl + v_rd_base(lane_id() & 63) + (b) * AV_BYTES; VFrag fa_, fb_; \
            pv_reads<0>(fa_, vb_); \
            pv_reads<1>(fb_, vb_); PV_WAIT8(); pv_mma(o[0], fa_, pa0, pa1, pa2, pa3); \
            pv_reads<2>(fa_, vb_); PV_WAIT8(); pv_mma(o[1], fb_, pa0, pa1, pa2, pa3); \
            DMA_STMT; \
            pv_reads<3>(fb_, vb_); PV_WAIT8(); pv_mma(o[2], fa_, pa0, pa1, pa2, pa3); \
            pv_reads<4>(fa_, vb_); PV_WAIT8(); pv_mma(o[3], fb_, pa0, pa1, pa2, pa3); \
            pv_reads<5>(fb_, vb_); PV_WAIT8(); pv_mma(o[4], fa_, pa0, pa1, pa2, pa3); \
            pv_reads<6>(fa_, vb_); PV_WAIT8(); pv_mma(o[5], fb_, pa0, pa1, pa2, pa3); \
            pv_reads<7>(fb_, vb_); PV_WAIT8(); pv_mma(o[6], fa_, pa0, pa1, pa2, pa3); \
            PV_WAIT0(); pv_mma(o[7], fb_, pa0, pa1, pa2, pa3); } while (0)
            f32x16 o[8];
#pragma unroll
            for (int d = 0; d < 8; ++d)
#pragma unroll
                for (int r = 0; r < 16; ++r) o[d][r] = 0.f;
            float l_reg = 0.f; bf16x8 pa0, pa1, pa2, pa3;
            constexpr int NT = L / 64;
#define ATT_TSYNC() do { asm volatile("s_waitcnt vmcnt(0)" ::: "memory"); asm volatile("s_waitcnt lgkmcnt(0)" ::: "memory"); __builtin_amdgcn_s_barrier(); asm volatile("" ::: "memory"); } while (0)
            __syncthreads();
            ATT_DMA_K(0, 0); ATT_DMA_V(0, 0); VM_WAIT(); __syncthreads();
            if (wid < 4) {
                int v3 = 0;
#pragma unroll 1
                for (int j = 0; j < NT; ++j) { const int b = j & 1, vn = v3 == 2 ? 0 : v3 + 1, jn = j + 1 < NT ? j + 1 : NT - 1;
                    ATT_QKSM(b, ATT_DMA_K(jn, b ^ 1), ATT_CONV()); SBAR(); asm volatile("" ::: "memory");
                    ATT_PV(v3, ATT_DMA_V(jn, vn));
                    ATT_TSYNC(); v3 = vn; ATT_CONV_NEXT(); }
            } else {
                int v3 = 0;
#pragma unroll 1
                for (int j = 0; j < NT; ++j) { const int b = j & 1, vn = v3 == 2 ? 0 : v3 + 1, vp = v3 == 0 ? 2 : v3 - 1, jn = j + 1 < NT ? j + 1 : NT - 1;
                    ATT_DMA_V(jn, vn); ATT_CONV(); asm volatile("" ::: "memory");
                    if (j > 0) ATT_PV(vp, (void)0);
                    SBAR(); asm volatile("" ::: "memory");
                    ATT_QKSM(b, ATT_DMA_K(jn, b ^ 1), (void)0);
                    ATT_TSYNC(); v3 = vn; ATT_CONV_NEXT(); }
                ATT_PV((NT - 1) % 3, (void)0); asm volatile("s_waitcnt lgkmcnt(0)" ::: "memory");
            }
#undef ATT_TSYNC
#undef ATT_DMA_K
#undef ATT_DMA_V
#undef ATT_HSYNC
#undef ATT_QKSM
#undef ATT_PV
#undef PK4
            int le = lane; asm volatile("" : "+v"(le));
            const int r32e = le & 31, hie = le >> 5;
            const float lt = add_xor32(l_reg);
            if (hie == 0) wsf[r32e] = lt;
            LDS_WAIT();
            float rli[16];
#pragma unroll
            for (int r = 0; r < 16; ++r) rli[r] = __builtin_amdgcn_rcpf(wsf[crow(r, hie)]);
            LDS_WAIT();
            GAS float* sp = (GAS float*)(WSP(float, WS_ATT) + ((size_t)(u * NWAVES + wid) * 128) * 64 + le);
            if (t == 0) {
#pragma unroll
                for (int d = 0; d < 8; ++d) {
#pragma unroll
                    for (int r = 0; r < 16; ++r) sp[(d * 16 + r) * 64] = o[d][r] * rli[r];
                    asm volatile("" ::: "memory"); }
            } else {
                float ss[16];
#pragma unroll
                for (int r = 0; r < 16; ++r) ss[r] = 0.f;
#pragma unroll
                for (int d = 0; d < 8; ++d) {
#pragma unroll
                    for (int r = 0; r < 16; ++r) { const float v = sp[(d * 16 + r) * 64] - lam * (o[d][r] * rli[r]); ss[r] += v * v; sp[(d * 16 + r) * 64] = v; }
                    asm volatile("" ::: "memory"); }
#pragma unroll
                for (int r = 0; r < 16; ++r) { float s = sum32(ss[r]);
                    ss[r] = __builtin_amdgcn_rsqf(s * (1.0f / DV2) + NORM_EPS); }
                GAS bf16_t* op = (GAS bf16_t*)(OD + (size_t)(qb * 256 + wid * 32 + 4 * hie) * DM + h * DV2 + r32e);
#pragma unroll
                for (int r = 0; r < 16; ++r) {
                    GAS bf16_t* opr = op + ((r & 3) + 8 * (r >> 2)) * DM;
#pragma unroll
                    for (int d = 0; d < 8; ++d) opr[d * 32] = (bf16_t)f2bf(sp[(d * 16 + r) * 64] * ss[r]);
                    asm volatile("" ::: "memory"); }
            }
        }
    }
}

#undef ATT_CONV
#undef ATT_CONV_NEXT
#undef CONV_DESC
constexpr int PH_PER_LAYER = 8, N_PHASES = 1 + NLAYER * PH_PER_LAYER;
__global__ void __launch_bounds__(NWAVES * 64, 2) fwd(Args args) {
    extern __shared__ __attribute__((aligned(16))) unsigned char lds[];
    Frame F;
    F.lds = (LAS unsigned char*)lds; F.ws = args.ws;
    F.wave = __builtin_amdgcn_readfirstlane((int)threadIdx.x >> 6); F.lane = lane_id() & 63; F.tid = F.wave * 64 + F.lane; F.G = gridDim.x;
    volatile LAS unsigned* MISC = (volatile LAS unsigned*)(F.lds + MISC_OFF);
    if (F.tid < 32) MISC[F.tid] = 0u;
    __syncthreads();
    const int lo = args.ph_lo, hi = args.ph_hi;
    unsigned* barw = (unsigned*)(F.ws + WS_CTL) + CW_BAR;
    XcdBarrier bar; bar.bar = barw; bar.x = 0; bar.st = MISC + 8;
    if (hi - lo > 1) bar = xcd_barrier_post(barw, MISC + 8, F.wave == 0 && lane_id() == 0);
#define IN(k) (lo <= (k) && (k) < hi)
#define SEAM(k) do { if (IN(k) && IN((k) + 1)) { XcdBarrier b_ = bar; unsigned* bw_ = b_.bar; asm volatile("" : "+s"(bw_)); b_.bar = bw_; xcd_barrier(b_, F.wave == 0 && lane_id() == 0); } } while (0)
    if (IN(0)) p0_prologue(F, args);
    SEAM(0);
#pragma unroll 1
    for (int l = 0; l < NLAYER; ++l) {
        const int pb = 1 + l * PH_PER_LAYER;
        const Args& A = args;
        { unsigned char* w_ = A.ws; asm volatile("" : "+s"(w_)); F.ws = w_; int t_ = lane_id(); asm volatile("" : "+v"(t_)); F.lane = t_ & 63; F.tid = F.wave * 64 + F.lane; }
        unsigned char* wl = F.ws + WS_W + (size_t)l * W_LAYER;
        float* ssqp = WSP(float, WS_SSQP);
        if (IN(pb + 0)) {
            pg8::Gemm g{WSP(bf16_t, WS_XB), (const bf16_t*)(wl + W_IN), L, INC, DM}; pg8::StaticOrder S; S.init(L, INC, F.G, (int)blockIdx.x);
            EpiInProj E{ssqp + (size_t)(2 * l) * L * 32, WSP(float, WS_ROPE), F.ws, (LAS float*)(F.lds + 131072), A.in[7] + l * HD, A.in[8] + l * HD};
            pg8::gemm_phase<EpiInProj, pg8::StaticOrder, true, true>(F.lds, g, S, E, F.wave);
        }
        SEAM(pb + 0);
        if (IN(pb + 1)) phase_r1(F, A, l);
        SEAM(pb + 1);
        if (IN(pb + 2)) phase_r2(F, A, l);
        SEAM(pb + 2);
        if (IN(pb + 3)) phase_r3(F, A, l);
        if (IN(pb + 3)) phase_attn(F, A, l);
        SEAM(pb + 3);
        if (IN(pb + 4)) {
            { pg8::Gemm g{WSP(bf16_t, WS_URET), (const bf16_t*)(wl + W_RO), L, DM, DM}; pg8::StaticOrder S; S.init(L, DM, F.G, (int)blockIdx.x);
              EpiGateA E{WSP(bf16_t, WS_SGR), WSP(float, WS_T1)};
              pg8::gemm_phase<EpiGateA, pg8::StaticOrder, true, true>(F.lds, g, S, E, F.wave); }
            VM_WAIT(); __syncthreads();
            { pg8::Gemm g{WSP(bf16_t, WS_ODIFF), (const bf16_t*)(wl + W_DO), L, DM, DM}; pg8::StaticOrder S; S.init(L, DM, F.G, (int)blockIdx.x);
              EpiGateB E{WSP(bf16_t, WS_SGD), WSP(float, WS_T1), WSP(bf16_t, WS_MERGED)};
              pg8::gemm_phase<EpiGateB, pg8::StaticOrder, true, true>(F.lds, g, S, E, F.wave); }
        }
        SEAM(pb + 4);
        if (IN(pb + 5)) {
            pg8::Gemm g{WSP(bf16_t, WS_MERGED), (const bf16_t*)(wl + W_OUT), L, DM, DM}; pg8::StaticOrder S; S.init(L, DM, F.G, (int)blockIdx.x);
            EpiResid E{l == 0 ? A.in[0] : (const float*)A.out, A.out, WSP(bf16_t, WS_XB), ssqp + (size_t)(2 * l + 1) * L * 32};
            pg8::gemm_phase<EpiResid, pg8::StaticOrder, true, true>(F.lds, g, S, E, F.wave);
        }
        SEAM(pb + 5);
        if (IN(pb + 6)) {
            pg8::Gemm g{WSP(bf16_t, WS_XB), (const bf16_t*)(wl + W_1), L, DFF, DM}; pg8::StaticOrder S; S.init(L, DFF, F.G, (int)blockIdx.x);
            EpiMlpIn E{ssqp + (size_t)(2 * l + 1) * L * 32, WSP(bf16_t, WS_UMLP)};
            pg8::gemm_phase<EpiMlpIn, pg8::StaticOrder, true, true>(F.lds, g, S, E, F.wave);
        }
        SEAM(pb + 6);
        if (IN(pb + 7)) {
            pg8::Gemm g{WSP(bf16_t, WS_UMLP), (const bf16_t*)(wl + W_2), L, DM, DFF}; pg8::StaticOrder S; S.init(L, DM, F.G, (int)blockIdx.x);
            EpiResid E{(const float*)A.out, A.out, WSP(bf16_t, WS_XB), ssqp + (size_t)(2 * l + 2) * L * 32};
            pg8::gemm_phase<EpiResid, pg8::StaticOrder, true, true>(F.lds, g, S, E, F.wave);
            if (l + 1 < NLAYER && F.G != 256) { VM_WAIT(); __syncthreads(); conv_layer(F, A, l + 1); }
        }
        SEAM(pb + 7);
    }
#undef IN
#undef SEAM
}


extern "C" void kernel_launch(void* const* d_in, const int* in_sizes, int n_in, void* d_out, int out_size, void* d_ws, size_t ws_size, hipStream_t stream) {
    static int grid = 0;
    if (grid == 0) {
        if (n_in != 16 || in_sizes[0] != L * DM || out_size != L * DM || ws_size < WS_END) {
            fprintf(stderr, "kernel_launch: shape mismatch: n_in %d in0 %d out %d ws %zu (need >= %zu); nothing launched\n", n_in, n_in > 0 ? in_sizes[0] : -1, out_size, ws_size, (size_t)WS_END); grid = -1; return; }
        int dev = 0, cus = 0;
        if (hipGetDevice(&dev) != hipSuccess || hipDeviceGetAttribute(&cus, hipDeviceAttributeMultiprocessorCount, dev) != hipSuccess) { fprintf(stderr, "kernel_launch: device query failed\n"); grid = -1; return; }
        if (hipFuncSetAttribute((const void*)fwd, hipFuncAttributeMaxDynamicSharedMemorySize, LDS_BYTES) != hipSuccess) { fprintf(stderr, "kernel_launch: hipFuncSetAttribute failed\n"); grid = -1; return; }
        int per_cu = 0;
        if (hipOccupancyMaxActiveBlocksPerMultiprocessor(&per_cu, (const void*)fwd, NWAVES * 64, LDS_BYTES) != hipSuccess || per_cu < 1)
            fprintf(stderr, "kernel_launch: note: occupancy query reports %d workgroups per CU\n", per_cu);
        (void)hipGetLastError();
        grid = cus > 256 ? 256 : cus;
    }
    if (grid < 0) return;
    (void)hipMemsetAsync((char*)d_ws + WS_CTL, 0, CTL_ZERO_BYTES, stream);
    Args a{};
    for (int i = 0; i < 16; ++i) a.in[i] = (const float*)d_in[i];
    a.out = (float*)d_out; a.ws = (unsigned char*)d_ws;
    for (int j = 0; j < 64; ++j) { const float pw = (float)std::pow(10000.0, (double)((float)(2 * j) / 128.0f)); a.inv[j] = 1.0f / pw; }
    for (int l = 0; l < 4; ++l) { const double li = 0.8 - 0.6 * std::exp(-0.3 * (double)l); a.lam_init[l] = (float)li; a.om_lam_init[l] = (float)(1.0 - li); }
#if MK_ONE_LAUNCH
    a.ph_lo = 0; a.ph_hi = N_PHASES;
    hipLaunchKernelGGL(fwd, dim3(grid), dim3(NWAVES * 64), LDS_BYTES, stream, a);
#else
    for (int ph = 0; ph < N_PHASES; ++ph) { a.ph_lo = ph; a.ph_hi = ph + 1; hipLaunchKernelGGL(fwd, dim3(grid), dim3(NWAVES * 64), LDS_BYTES, stream, a); }
#endif
    const hipError_t le = hipPeekAtLastError();
    if (le != hipSuccess) fprintf(stderr, "kernel_launch: launch failed: %s\n", hipGetErrorName(le));
}
```

```cpp
#include <hip/hip_runtime.h>
#include <cstdio>
#include <cstdint>
#include <cmath>

#ifndef MK_ONE_LAUNCH
#define MK_ONE_LAUNCH 1
#endif

constexpr int L = 8192, DM = 2048, NLAYER = 4, INC = 16384, DFF = 8192, HD = 128, NH = 8, DV2 = 256, CH = 128, NCH = L / CH;
constexpr float NORM_EPS = 1e-6f, GN_EPS = 1e-5f;
constexpr int NWAVES = 8;
namespace pg8 {
#define PG8_LAS __attribute__((address_space(3)))
typedef unsigned short bf16_t;
typedef short bf16x8 __attribute__((ext_vector_type(8)));
typedef float f32x4 __attribute__((ext_vector_type(4)));
typedef unsigned u32x4 __attribute__((ext_vector_type(4)));
constexpr int BM = 256, BK = 64, HALF = 128, HTB = HALF * BK * 2  , STAGE_BYTES = 8 * HTB, NXCD = 8, WGM = 4;

__host__ __device__ __forceinline__ int lds_byte(int r, int c) { const int st = (r >> 4) * 2 + (c >> 5), rr = r & 15, cc = c & 31, ob = rr * 64 + cc * 2; return st * 1024 + (ob ^ (((ob >> 9) & 1) << 5)); }
__host__ __device__ __forceinline__ void stage_rc(int b, int& R, int& C) { const int st = b / 1024, sb = b % 1024, swz = sb ^ (((sb >> 9) & 1) << 5); R = (st >> 1) * 16 + swz / 64; C = (st & 1) * 32 + (swz % 64) / 2; }
__host__ __device__ __forceinline__ int perm32(int rho) { const int n = rho >> 4, i = rho & 15; return 8 * (i >> 2) + 4 * n + (i & 3); }

struct Unit { int pm, pn; };
struct Gemm { const bf16_t* A; const bf16_t* Bt; int M, N, K; };

struct StaticOrder {
    int nM, nN, nwg, G, c;
    __host__ __device__ void init(int M, int N, int G_, int c_) { nM = M / BM; nN = N / BM; nwg = nM * nN; G = G_; c = c_; }
    __host__ __device__ bool next(int i, Unit& u) const {
        const long L = (long)i * G + c; if (L >= nwg) return false;
        int wgid = (int)L; { const int q = nwg / NXCD, r = nwg % NXCD, xcd = wgid % NXCD, off = wgid / NXCD; wgid = (xcd < r ? xcd * (q + 1) : r * (q + 1) + (xcd - r) * q) + off; }
        const int nig = WGM * nN, gid = wgid / nig, fm = gid * WGM, gsz = (nM - fm) < WGM ? (nM - fm) : WGM;
        u.pm = fm + ((wgid % nig) % gsz); u.pn = (wgid % nig) / gsz; return true;
    }
    __device__ __forceinline__ void a_ready(const Unit&) const {}
    __device__ __forceinline__ void done(const Unit&) const {}
};
template <class Epi, class Sched, bool ALIGN_EPI = false, bool SP2 = false>
__device__ __forceinline__ void gemm_phase(PG8_LAS unsigned char* lds, const Gemm g, const Sched& S, const Epi& E, const int wid_in  ) {
    int lane_; asm volatile("v_mbcnt_lo_u32_b32 %0, -1, 0\n\tv_mbcnt_hi_u32_b32 %0, -1, %0" : "=v"(lane_)); int wid_ = wid_in; asm volatile("" : "+s"(wid_)); const int wid = wid_ & 7, tid = wid * 64 + (lane_ & 63), lane = tid & 63, wr = wid >> 2, wc = wid & 3, fr = lane & 15, fq = lane >> 4;
    const int K = g.K, nt = K / BK;
    unsigned voffA[2], voffB[2];
#pragma unroll
    for (int i = 0; i < 2; ++i) { int R, C; stage_rc(tid * 16 + i * 8192, R, C); const int Rb = Epi::PERM ? ((R & ~31) + perm32(R & 31)) : R;
        voffA[i] = (unsigned)(R * K + C) * 2u; voffB[i] = (unsigned)(Rb * K + C) * 2u; }
    const size_t kstep = (size_t)(BK * 2);
    const size_t hstep = (size_t)HALF * K * 2;
    const size_t tstep = 2 * hstep;
    const unsigned ldsw = (unsigned)wid * 1024u;
    const int aoff = lds_byte(wr * 64 + fr, fq * 8), boff = lds_byte(wc * 32 + fr, fq * 8);
#define PG8_SA(b, h) (((b) * 2 + (h)) * HTB)
#define PG8_SB(b, h) ((4 + (b) * 2 + (h)) * HTB)
#define PG8_STAGE(bufoff, gbase, voff) do { _Pragma("unroll") for (int _i = 0; _i < 2; ++_i) \
        __builtin_amdgcn_global_load_lds((const unsigned*)((const char*)(gbase) + (voff)[_i]), (PG8_LAS unsigned*)(lds + (bufoff) + ldsw + _i * 8192), 16, 0, 0); } while (0)
#define PG8_LDA(dst, b, h) do { _Pragma("unroll") for (int m = 0; m < 4; ++m) _Pragma("unroll") for (int k = 0; k < 2; ++k) dst[m][k] = *(const PG8_LAS bf16x8*)(lds + PG8_SA(b, h) + aoff + m * 2048 + k * 1024); } while (0)
#define PG8_LDB(dst, b, h) do { _Pragma("unroll") for (int n = 0; n < 2; ++n) _Pragma("unroll") for (int k = 0; k < 2; ++k) dst[n][k] = *(const PG8_LAS bf16x8*)(lds + PG8_SB(b, h) + boff + n * 2048 + k * 1024); } while (0)
#define PG8_MMA(ai, bj, At, Bt) do { __builtin_amdgcn_s_setprio(1); _Pragma("unroll") for (int m = 0; m < 4; ++m) _Pragma("unroll") for (int n = 0; n < 2; ++n) _Pragma("unroll") for (int k = 0; k < 2; ++k) \
        acc[ai][bj][m][n] = __builtin_amdgcn_mfma_f32_16x16x32_bf16(Bt[n][k], At[m][k], acc[ai][bj][m][n], 0, 0, 0); __builtin_amdgcn_s_setprio(0); } while (0)
#define PG8_WAIT_V(n) asm volatile("s_waitcnt vmcnt(" #n ")" ::: "memory")
#define PG8_WAIT_L(n) asm volatile("s_waitcnt lgkmcnt(" #n ")" ::: "memory")
#define PG8_BAR __builtin_amdgcn_s_barrier()
#define PG8_SCHED __builtin_amdgcn_sched_barrier(0)
    Unit cur, nxt; int ui = 0;
    if (!S.next(0, cur)) return;
    f32x4 acc[2][2][4][2];
#pragma unroll
    for (int a = 0; a < 2; ++a)
#pragma unroll
        for (int b = 0; b < 2; ++b)
#pragma unroll
            for (int m = 0; m < 4; ++m)
#pragma unroll
                for (int n = 0; n < 2; ++n) acc[a][b][m][n] = (f32x4){0.f, 0.f, 0.f, 0.f};
    bf16x8 At[4][2], B0[2][2], B1[2][2];
    const char* cA = (const char*)g.A + (size_t)cur.pm * tstep; const char* cB = (const char*)g.Bt + (size_t)cur.pn * tstep;
    S.a_ready(cur);
    if constexpr (SP2) {
        PG8_STAGE(PG8_SB(0, 0), cB, voffB); PG8_STAGE(PG8_SB(0, 1), cB + hstep, voffB); PG8_STAGE(PG8_SA(0, 0), cA, voffA); PG8_STAGE(PG8_SA(0, 1), cA + hstep, voffA);
        if (wr == 1) PG8_BAR;
        PG8_WAIT_V(2); PG8_BAR;
        PG8_STAGE(PG8_SB(1, 0), cB + kstep, voffB); PG8_STAGE(PG8_SA(1, 0), cA + kstep, voffA); PG8_STAGE(PG8_SB(1, 1), cB + hstep + kstep, voffB);
        PG8_WAIT_V(6); PG8_BAR;
    } else {
        PG8_STAGE(PG8_SB(0, 0), cB, voffB); PG8_STAGE(PG8_SA(0, 0), cA, voffA); PG8_STAGE(PG8_SB(0, 1), cB + hstep, voffB); PG8_STAGE(PG8_SA(0, 1), cA + hstep, voffA);
        if (wr == 1) PG8_BAR;
        PG8_WAIT_V(4); PG8_BAR;
        PG8_STAGE(PG8_SB(1, 0), cB + kstep, voffB); PG8_STAGE(PG8_SA(1, 0), cA + kstep, voffA); PG8_STAGE(PG8_SB(1, 1), cB + hstep + kstep, voffB);
        PG8_WAIT_V(6); PG8_BAR;
    }
    for (;;) {
        const bool has_next = S.next(ui + 1, nxt);
        const char* nA = has_next ? (const char*)g.A + (size_t)nxt.pm * tstep : cA; const char* nB = has_next ? (const char*)g.Bt + (size_t)nxt.pn * tstep : cB;
        for (int t = 0; t < nt; t += 2) {
            const bool last = (t == nt - 2);
            const char* a1 = cA + (size_t)(t + 1) * kstep;
            const char* a2 = last ? nA : cA + (size_t)(t + 2) * kstep; const char* b2 = last ? nB : cB + (size_t)(t + 2) * kstep;
            const char* a3 = a2 + kstep; const char* b3 = b2 + kstep;
            if (last && has_next) S.a_ready(nxt);
            if constexpr (SP2) {
            PG8_LDB(B0, 0, 0); PG8_LDB(B1, 0, 1); PG8_SCHED; PG8_LDA(At, 0, 0); PG8_STAGE(PG8_SA(1, 1), a1 + hstep, voffA);
            PG8_WAIT_V(8); PG8_WAIT_L(0); PG8_BAR; PG8_MMA(0, 0, At, B0); PG8_MMA(0, 1, At, B1); PG8_BAR; PG8_SCHED;
            PG8_LDA(At, 0, 1); PG8_STAGE(PG8_SB(0, 0), b2, voffB); PG8_STAGE(PG8_SB(0, 1), b2 + hstep, voffB); PG8_STAGE(PG8_SA(0, 0), a2, voffA);
            PG8_WAIT_V(8); PG8_WAIT_L(0); PG8_BAR; PG8_MMA(1, 0, At, B0); PG8_MMA(1, 1, At, B1); PG8_BAR; PG8_SCHED;
            PG8_LDB(B0, 1, 0); PG8_LDB(B1, 1, 1); PG8_SCHED; PG8_LDA(At, 1, 0); PG8_STAGE(PG8_SA(0, 1), a2 + hstep, voffA);
            PG8_WAIT_V(8); PG8_WAIT_L(0); PG8_BAR; PG8_MMA(0, 0, At, B0); PG8_MMA(0, 1, At, B1); PG8_BAR; PG8_SCHED;
            PG8_LDA(At, 1, 1); PG8_STAGE(PG8_SB(1, 0), b3, voffB); PG8_STAGE(PG8_SB(1, 1), b3 + hstep, voffB); PG8_STAGE(PG8_SA(1, 0), a3, voffA);
            PG8_WAIT_V(8); PG8_WAIT_L(0); PG8_BAR; PG8_MMA(1, 0, At, B0); PG8_MMA(1, 1, At, B1); PG8_BAR; PG8_SCHED;
            } else {
            PG8_LDB(B0, 0, 0); PG8_SCHED; PG8_LDA(At, 0, 0); PG8_STAGE(PG8_SA(1, 1), a1 + hstep, voffA);
            PG8_WAIT_L(8); PG8_BAR; PG8_WAIT_L(0); PG8_MMA(0, 0, At, B0); PG8_BAR; PG8_SCHED;
            PG8_LDB(B1, 0, 1); PG8_STAGE(PG8_SB(0, 0), b2, voffB);
            PG8_BAR; PG8_WAIT_L(0); PG8_MMA(0, 1, At, B1); PG8_BAR;
            PG8_LDA(At, 0, 1); PG8_STAGE(PG8_SA(0, 0), a2, voffA);
            PG8_BAR; PG8_WAIT_L(0); PG8_MMA(1, 0, At, B0); PG8_BAR; PG8_SCHED;
            PG8_STAGE(PG8_SB(0, 1), b2 + hstep, voffB);
            PG8_WAIT_V(6); PG8_BAR; PG8_MMA(1, 1, At, B1); PG8_BAR;
            PG8_LDB(B0, 1, 0); PG8_SCHED; PG8_LDA(At, 1, 0); PG8_STAGE(PG8_SA(0, 1), a2 + hstep, voffA);
            PG8_WAIT_L(8); PG8_BAR; PG8_WAIT_L(0); PG8_MMA(0, 0, At, B0); PG8_BAR; PG8_SCHED;
            PG8_LDB(B1, 1, 1); PG8_STAGE(PG8_SB(1, 0), b3, voffB);
            PG8_BAR; PG8_WAIT_L(0); PG8_MMA(0, 1, At, B1); PG8_BAR;
            PG8_LDA(At, 1, 1); PG8_STAGE(PG8_SA(1, 0), a3, voffA);
            PG8_BAR; PG8_WAIT_L(0); PG8_MMA(1, 0, At, B0); PG8_BAR; PG8_SCHED;
            PG8_STAGE(PG8_SB(1, 1), b3 + hstep, voffB);
            PG8_WAIT_V(6); PG8_BAR; PG8_MMA(1, 1, At, B1); PG8_BAR;
            }
        }
        if constexpr (ALIGN_EPI) { if (wr == 0) PG8_BAR; }
        if constexpr (!Epi::AFTER_DRAIN) { E(acc, cur, wr, wc, fr, fq); S.done(cur); }
        if (!has_next) break;
#pragma unroll
        for (int a = 0; a < 2; ++a)
#pragma unroll
            for (int b = 0; b < 2; ++b)
#pragma unroll
                for (int m = 0; m < 4; ++m)
#pragma unroll
                    for (int n = 0; n < 2; ++n) acc[a][b][m][n] = (f32x4){0.f, 0.f, 0.f, 0.f};
        cur = nxt; cA = nA; cB = nB; ++ui;
        if constexpr (ALIGN_EPI) { if (wr == 1) PG8_BAR; }
    }
    PG8_WAIT_V(0);
    if constexpr (!ALIGN_EPI) { if (wr == 0) PG8_BAR; }
    PG8_BAR;
    if constexpr (Epi::AFTER_DRAIN) { E.fused(acc, cur, wr, wc, fr, fq, lds, wid, lane); S.done(cur); }
#undef PG8_SA
#undef PG8_SB
#undef PG8_STAGE
#undef PG8_LDA
#undef PG8_LDB
#undef PG8_MMA
#undef PG8_WAIT_V
#undef PG8_WAIT_L
#undef PG8_BAR
#undef PG8_SCHED
}
}

constexpr size_t MiB = 1u << 20;
constexpr size_t WS_CTL = 0, CTL_ZERO_BYTES = 1 * MiB;
constexpr size_t WS_CONST = 2 * MiB;
constexpr size_t WS_ROPE = 4 * MiB;
constexpr size_t WS_W = 16 * MiB, W_LAYER = 152 * MiB;
constexpr size_t W_IN = 0, W_RO = 64 * MiB, W_DO = 72 * MiB, W_OUT = 80 * MiB, W_1 = 88 * MiB, W_2 = 120 * MiB;
constexpr size_t WS_XB = 640 * MiB, WS_QR = 672 * MiB, WS_KR = 688 * MiB, WS_VR = 704 * MiB, WS_GR = 736 * MiB, WS_DQ = 768 * MiB, WS_DK = 800 * MiB,
                 WS_DV = 832 * MiB, WS_SGR = 864 * MiB, WS_SGD = 896 * MiB, WS_KVF = 928 * MiB, WS_KVB = 992 * MiB, WS_STF = 1056 * MiB, WS_STB = 1088 * MiB,
                 WS_URET = 1120 * MiB, WS_ODIFF = 1152 * MiB, WS_T1 = 1184 * MiB, WS_MERGED = 1248 * MiB, WS_UMLP = 1280 * MiB, WS_ATT = 1408 * MiB, WS_SSQP = 1472 * MiB, WS_END = 1488 * MiB;
constexpr int CW_TMO = 0, CW_BAR = 4096;

constexpr int LDS_BYTES = 155648;
constexpr int MISC_OFF = 153600;

#define GAS __attribute__((address_space(1)))
#define LAS __attribute__((address_space(3)))
typedef unsigned short bf16_t;
typedef unsigned v4u __attribute__((ext_vector_type(4)));
typedef unsigned v2u __attribute__((ext_vector_type(2)));
typedef float f32x4 __attribute__((ext_vector_type(4)));
typedef float f32x16 __attribute__((ext_vector_type(16)));
typedef short bf16x8 __attribute__((ext_vector_type(8)));
typedef short s16x4 __attribute__((ext_vector_type(4)));
typedef GAS unsigned gu32;
#define RLX_AGENT __ATOMIC_RELAXED, __HIP_MEMORY_SCOPE_AGENT
#define LDS_WAIT() asm volatile("s_waitcnt lgkmcnt(0)" ::: "memory")
#define VM_WAIT() asm volatile("s_waitcnt vmcnt(0)" ::: "memory")
#define SBAR() __builtin_amdgcn_sched_barrier(0)
__device__ __forceinline__ unsigned f2bf(float f) { unsigned u = __builtin_bit_cast(unsigned, f); return (u + 0x7fffu + ((u >> 16) & 1u)) >> 16; }
__device__ __forceinline__ unsigned pk2(float lo, float hi) { return f2bf(lo) | (f2bf(hi) << 16); }
__device__ __forceinline__ float bf2f(unsigned short b) { return __builtin_bit_cast(float, (unsigned)b << 16); }
__device__ __forceinline__ float bflo(unsigned w) { return __builtin_bit_cast(float, w << 16); }
__device__ __forceinline__ float bfhi(unsigned w) { return __builtin_bit_cast(float, w & 0xffff0000u); }
__device__ __forceinline__ unsigned cvtpk(float lo, float hi) { unsigned r; asm volatile("v_cvt_pk_bf16_f32 %0, %1, %2" : "=v"(r) : "v"(lo), "v"(hi)); return r; }
__device__ __forceinline__ int crow(int r, int hi) { return (r & 3) + 8 * (r >> 2) + 4 * hi; }
__device__ __forceinline__ int lane_id() { int l; asm volatile("v_mbcnt_lo_u32_b32 %0, -1, 0\n\tv_mbcnt_hi_u32_b32 %0, -1, %0" : "=v"(l)); return l; }
template <int M> __device__ __forceinline__ float sw_xor(float v) { return __builtin_bit_cast(float, __builtin_amdgcn_ds_swizzle(__builtin_bit_cast(int, v), (M << 10) | 0x1f)); }
__device__ __forceinline__ void swap32(float& a, float& b) { asm volatile("s_nop 1\n\tv_permlane32_swap_b32 %0, %1\n\ts_nop 1" : "+v"(a), "+v"(b)); }
__device__ __forceinline__ float add_xor32(float v) { float a = v, b = v; swap32(a, b); return a + b; }
__device__ __forceinline__ float max_xor32(float v) { float a = v, b = v; swap32(a, b); return fmaxf(a, b); }
__device__ __forceinline__ float sum16(float v) { v += sw_xor<1>(v); v += sw_xor<2>(v); v += sw_xor<4>(v); v += sw_xor<8>(v); return v; }
__device__ __forceinline__ float sum32(float v) { v = sum16(v); v += sw_xor<16>(v); return v; }
__device__ __forceinline__ int opaque(int x) { asm volatile("" : "+v"(x)); return x & 511; }
__device__ __forceinline__ float wave_sum(float v) { return add_xor32(sum32(v)); }
__device__ __forceinline__ float wave_max(float v) { v = fmaxf(v, sw_xor<1>(v)); v = fmaxf(v, sw_xor<2>(v)); v = fmaxf(v, sw_xor<4>(v)); v = fmaxf(v, sw_xor<8>(v)); v = fmaxf(v, sw_xor<16>(v)); return max_xor32(v); }
__device__ __forceinline__ float fsigmoid(float x) { return __builtin_amdgcn_rcpf(1.f + __expf(-x)); }

#define XB_TMO      128
#define XB_XCNT(j)  (256  + 64 * (j))
#define XB_XSUB(j)  (1280 + 64 * (j))
#define XB_XGEN(j)  (2304 + 64 * (j))
#define XB_TOP      3328
#define XB_TOPGEN   3392
#define XCD_BAR_WORDS 3456
#define XB_SPIN_CAP (1u << 18)
__device__ __forceinline__ unsigned xb_ld(unsigned* p)              { return __hip_atomic_load(p, __ATOMIC_RELAXED, __HIP_MEMORY_SCOPE_AGENT); }
__device__ __forceinline__ unsigned xb_add(unsigned* p, unsigned v) { return __hip_atomic_fetch_add(p, v, __ATOMIC_RELAXED, __HIP_MEMORY_SCOPE_AGENT); }
__device__ __forceinline__ unsigned xb_xcc_id() { return (unsigned)__builtin_amdgcn_s_getreg((3 << 11) | 20) & 0xFu; }
#define XB_SPIN(cond, bar) do { unsigned _sp = 0; while (cond) { __builtin_amdgcn_s_sleep(1); \
    if ((++_sp & 255u) == 0u) { if (xb_ld(&(bar)[XB_TMO])) break; if (_sp > XB_SPIN_CAP) { atomicAdd(&(bar)[XB_TMO], 1u); break; } } } } while (0)
struct XcdBarrier { unsigned* bar; unsigned x; volatile LAS unsigned* st; };
__device__ __forceinline__ XcdBarrier xcd_barrier_post(unsigned* bar, volatile LAS unsigned* st, bool leader) {
    XcdBarrier b; b.bar = bar; b.x = xb_xcc_id(); b.st = st;
    if (leader) (void)xb_add(&bar[XB_XCNT(b.x)], 1u);
    return b;
}
__device__ __forceinline__ void xcd_barrier_complete(unsigned* bar, unsigned x, unsigned& nloc, unsigned& nx) {
    const unsigned G = gridDim.x * gridDim.y * gridDim.z;
    unsigned sum, cnt, mine, sp = 0u;
    for (;;) {
        sum = 0u; cnt = 0u; mine = 0u;
#pragma unroll
        for (unsigned j = 0; j < 16; ++j) { const unsigned c = xb_ld(&bar[XB_XCNT(j)]); sum += c; cnt += (c > 0u) ? 1u : 0u; mine = (j == x) ? c : mine; }
        if (sum == G) break;
        __builtin_amdgcn_s_sleep(1);
        if ((++sp & 255u) == 0u) { if (xb_ld(&bar[XB_TMO])) break; if (sp > XB_SPIN_CAP) { atomicAdd(&bar[XB_TMO], 1u); break; } }
    }
    nloc = mine > 0u ? mine : 1u; nx = cnt > 0u ? cnt : 1u;
}
__device__ __forceinline__ void xcd_barrier(const XcdBarrier& b, bool leader  ) {
    asm volatile("s_waitcnt vmcnt(0)" ::: "memory");
    __syncthreads();
    if (leader) {
        unsigned* bar = b.bar;
        __builtin_amdgcn_s_waitcnt(0);
        unsigned nloc = b.st[0], nx = b.st[1];
        if (nloc == 0u) { xcd_barrier_complete(bar, b.x, nloc, nx); b.st[0] = nloc; b.st[1] = nx; }
        const unsigned old = xb_add(&bar[XB_XSUB(b.x)], 1u);
        const unsigned gen = old / nloc;
        if (old + 1u == (gen + 1u) * nloc) {
            __builtin_amdgcn_fence(__ATOMIC_RELEASE, "agent");
            asm volatile("s_waitcnt vmcnt(0)" ::: "memory");
            const unsigned og = xb_add(&bar[XB_TOP], 1u);
            const unsigned tg = og / nx;
            if (og + 1u == (tg + 1u) * nx) xb_add(&bar[XB_TOPGEN], 1u);
            else XB_SPIN(xb_ld(&bar[XB_TOPGEN]) == tg, bar);
            __builtin_amdgcn_fence(__ATOMIC_ACQUIRE, "agent");
            xb_add(&bar[XB_XGEN(b.x)], 1u);
            asm volatile("s_waitcnt vmcnt(0)" ::: "memory");
        } else {
            XB_SPIN(xb_ld(&bar[XB_XGEN(b.x)]) == gen, bar);
            __builtin_amdgcn_fence(__ATOMIC_ACQUIRE, "agent");
            asm volatile("s_waitcnt vmcnt(0)" ::: "memory");
        }
    }
    __syncthreads();
}

struct Args {
    const float* in[16]; float* out; unsigned char* ws;
    float inv[64];
    float om_lam_init[4];
    float lam_init[4];
    int ph_lo, ph_hi, pad0, pad1;
};
struct Frame {
    LAS unsigned char* lds;
    unsigned char* ws;
    int tid, lane, wave, G;
};
#define WSP(T, off) ((T*)(F.ws + (off)))

using pg8::Unit;
__device__ __forceinline__ void rows_rs(const float* ssqp, int row0, int fq, float (&rs)[2][4]) {
    f32x4 pa[2][4], pb[2][4];
#pragma unroll
    for (int ai = 0; ai < 2; ++ai)
#pragma unroll
        for (int m = 0; m < 4; ++m) { const f32x4* p = (const f32x4*)(ssqp + (size_t)(row0 + ai * 128 + m * 16) * 32) + 2 * fq; pa[ai][m] = p[0]; pb[ai][m] = p[1]; }
#pragma unroll
    for (int ai = 0; ai < 2; ++ai)
#pragma unroll
        for (int m = 0; m < 4; ++m) { const f32x4 q = pa[ai][m] + pb[ai][m]; float t = (q[0] + q[1]) + (q[2] + q[3]); t += sw_xor<16>(t); t = add_xor32(t);
            rs[ai][m] = __builtin_amdgcn_rsqf(t * (1.0f / DM) + NORM_EPS); }
}
struct EpiInProj {
    static constexpr bool PERM = true, AFTER_DRAIN = false;
    const float* ssqp; const float* cs; unsigned char* ws; LAS float* xch; const float* qw; const float* kw;
    __device__ __forceinline__ void operator()(const f32x4 (&acc)[2][2][4][2], const Unit& u, int wr, int wc, int fr_, int fq_) const {
        (void)fr_; (void)fq_; const int ln_ = lane_id() & 63, fr = ln_ & 15, fq = ln_ >> 4;
        const int pn = u.pn, seg = pn >> 2, id = seg < 2 ? seg : (seg >> 1) + 1;
        const size_t boff = WS_QR + (size_t)(id < 2 ? 16 * id : 32 * (id - 1)) * MiB;
        const int ld = id < 2 ? 1024 : 2048, cb = (pn - (id < 2 ? 4 * id : 8 * (id - 1))) * 256;
        const int op = id < 2 ? 1 : (id == 3 ? 2 : (id >= 7 ? 3 : ((id == 4 || id == 5) ? 4 : 0)));
        const float sc = id == 1 ? 0.08838834764831845f : 1.0f;
        bf16_t* base = (bf16_t*)(ws + boff);
        const int row0 = u.pm * 256 + wr * 64 + fr, col0 = cb + wc * 32 + 8 * fq, j0 = 16 * wc + 4 * fq;
        float rs[2][4]; rows_rs(ssqp, row0, fq, rs);
        if (op == 1) {
            f32x4 ca[2][4], cb4[2][4];
#pragma unroll
            for (int ai = 0; ai < 2; ++ai)
#pragma unroll
                for (int m = 0; m < 4; ++m) { const f32x4* cp = (const f32x4*)(cs + ((size_t)(row0 + ai * 128 + m * 16) * 64 + j0) * 2); ca[ai][m] = cp[0]; cb4[ai][m] = cp[1]; }
#pragma unroll
            for (int ai = 0; ai < 2; ++ai)
#pragma unroll
                for (int m = 0; m < 4; ++m) {
                    bf16_t* rowp = base + (size_t)(row0 + ai * 128 + m * 16) * ld + col0; const f32x4 c0 = ca[ai][m], c1 = cb4[ai][m]; const float r = rs[ai][m] * sc;
#pragma unroll
                    for (int bj = 0; bj < 2; ++bj) {
                        const f32x4 v0 = acc[ai][bj][m][0] * r, v1 = acc[ai][bj][m][1] * r;
                        v4u w; w.x = cvtpk(v0[0] * c0[0] - v0[1] * c0[1], v0[1] * c0[0] + v0[0] * c0[1]); w.y = cvtpk(v0[2] * c0[2] - v0[3] * c0[3], v0[3] * c0[2] + v0[2] * c0[3]);
                        w.z = cvtpk(v1[0] * c1[0] - v1[1] * c1[1], v1[1] * c1[0] + v1[0] * c1[1]); w.w = cvtpk(v1[2] * c1[2] - v1[3] * c1[3], v1[3] * c1[2] + v1[2] * c1[3]);
                        *(v4u*)(rowp + bj * 128) = w;
                    }
                }
        } else if (op == 4) {
            LAS float* xp = xch + wr * 1024;
#pragma unroll
            for (int ai = 0; ai < 2; ++ai)
#pragma unroll
                for (int m = 0; m < 4; ++m)
#pragma unroll
                    for (int bj = 0; bj < 2; ++bj) { const f32x4 v0 = acc[ai][bj][m][0], v1 = acc[ai][bj][m][1];
                        float ss = (v0[0] * v0[0] + v0[1] * v0[1]) + (v0[2] * v0[2] + v0[3] * v0[3]) + (v1[0] * v1[0] + v1[1] * v1[1]) + (v1[2] * v1[2] + v1[3] * v1[3]);
                        ss += sw_xor<16>(ss); ss = add_xor32(ss);
                        if (fq == 0) xp[((ai * 4 + m) * 16 + fr) * 8 + bj * 4 + wc] = ss; }
            asm volatile("s_waitcnt lgkmcnt(0)" ::: "memory"); __builtin_amdgcn_s_barrier(); asm volatile("" ::: "memory");
            const float* gw = (id == 4) ? qw : kw;
            const f32x4 w1 = *(const f32x4*)(gw + j0), w2 = *(const f32x4*)(gw + 64 + j0);
#pragma unroll
            for (int ai = 0; ai < 2; ++ai) {
                f32x4 ca[4], cb4[4];
#pragma unroll
                for (int m = 0; m < 4; ++m) { const f32x4* cp = (const f32x4*)(cs + ((size_t)(row0 + ai * 128 + m * 16) * 64 + j0) * 2); ca[m] = cp[0]; cb4[m] = cp[1]; }
#pragma unroll
                for (int m = 0; m < 4; ++m) {
                    bf16_t* rowp = base + (size_t)(row0 + ai * 128 + m * 16) * ld + col0; const f32x4 c0 = ca[m], c1 = cb4[m]; const float r = rs[ai][m];
#pragma unroll
                    for (int bj = 0; bj < 2; ++bj) {
                        const f32x4 t = *(const LAS f32x4*)(xp + ((ai * 4 + m) * 16 + fr) * 8 + bj * 4);
                        const float cn = r * __builtin_amdgcn_rsqf(((t[0] + t[1]) + (t[2] + t[3])) * (r * r) * (1.0f / HD) + NORM_EPS);
                        const f32x4 v0 = acc[ai][bj][m][0] * cn, v1 = acc[ai][bj][m][1] * cn;
                        const float a0 = v0[0] * w1[0], b0 = v0[1] * w2[0], a1 = v0[2] * w1[1], b1 = v0[3] * w2[1], a2 = v1[0] * w1[2], b2 = v1[1] * w2[2], a3 = v1[2] * w1[3], b3 = v1[3] * w2[3];
                        v4u w; w.x = cvtpk(a0 * c0[0] - b0 * c0[1], b0 * c0[0] + a0 * c0[1]); w.y = cvtpk(a1 * c0[2] - b1 * c0[3], b1 * c0[2] + a1 * c0[3]);
                        w.z = cvtpk(a2 * c1[0] - b2 * c1[1], b2 * c1[0] + a2 * c1[1]); w.w = cvtpk(a3 * c1[2] - b3 * c1[3], b3 * c1[2] + a3 * c1[3]);
                        *(v4u*)(rowp + bj * 128) = w;
                    }
                }
                asm volatile("" ::: "memory");
            }
        } else {
#pragma unroll
            for (int ai = 0; ai < 2; ++ai)
#pragma unroll
                for (int m = 0; m < 4; ++m) {
                    bf16_t* rowp = base + (size_t)(row0 + ai * 128 + m * 16) * ld + col0; const float r = rs[ai][m];
#pragma unroll
                    for (int bj = 0; bj < 2; ++bj) {
                        f32x4 v0 = acc[ai][bj][m][0] * r, v1 = acc[ai][bj][m][1] * r;
                        if (op == 2) {
#pragma unroll
                            for (int e = 0; e < 4; ++e) { v0[e] = v0[e] * fsigmoid(v0[e]); v1[e] = v1[e] * fsigmoid(v1[e]); }
                        } else if (op == 3) {
#pragma unroll
                            for (int e = 0; e < 4; ++e) { v0[e] = fsigmoid(v0[e]); v1[e] = fsigmoid(v1[e]); }
                        }
                        v4u w; w.x = cvtpk(v0[0], v0[1]); w.y = cvtpk(v0[2], v0[3]); w.z = cvtpk(v1[0], v1[1]); w.w = cvtpk(v1[2], v1[3]);
                        *(v4u*)(rowp + bj * 128) = w;
                    }
                }
        }
    }
};
struct EpiGateA {
    static constexpr bool PERM = true, AFTER_DRAIN = false;
    const bf16_t* sg; float* T1;
    __device__ __forceinline__ void operator()(const f32x4 (&acc)[2][2][4][2], const Unit& u, int wr, int wc, int fr_, int fq_) const {
        (void)fr_; (void)fq_; const int ln_ = lane_id() & 63, fr = ln_ & 15, fq = ln_ >> 4;
        const int row0 = u.pm * 256 + wr * 64 + fr, col0 = u.pn * 256 + wc * 32 + 8 * fq;
        v4u g[2][4][2];
#pragma unroll
        for (int ai = 0; ai < 2; ++ai)
#pragma unroll
            for (int m = 0; m < 4; ++m)
#pragma unroll
                for (int bj = 0; bj < 2; ++bj) g[ai][m][bj] = *(const v4u*)(sg + (size_t)(row0 + ai * 128 + m * 16) * DM + col0 + bj * 128);
#pragma unroll
        for (int ai = 0; ai < 2; ++ai)
#pragma unroll
            for (int m = 0; m < 4; ++m)
#pragma unroll
                for (int bj = 0; bj < 2; ++bj) {
                    const size_t off = (size_t)(row0 + ai * 128 + m * 16) * DM + col0 + bj * 128; const v4u q = g[ai][m][bj];
                    f32x4 v0 = acc[ai][bj][m][0], v1 = acc[ai][bj][m][1];
                    v0[0] *= bflo(q.x); v0[1] *= bfhi(q.x); v0[2] *= bflo(q.y); v0[3] *= bfhi(q.y);
                    v1[0] *= bflo(q.z); v1[1] *= bfhi(q.z); v1[2] *= bflo(q.w); v1[3] *= bfhi(q.w);
                    *(f32x4*)(T1 + off) = v0; *(f32x4*)(T1 + off + 4) = v1;
                }
    }
};
struct EpiGateB {
    static constexpr bool PERM = true, AFTER_DRAIN = false;
    const bf16_t* sg; const float* T1; bf16_t* out;
    __device__ __forceinline__ void operator()(const f32x4 (&acc)[2][2][4][2], const Unit& u, int wr, int wc, int fr_, int fq_) const {
        (void)fr_; (void)fq_; const int ln_ = lane_id() & 63, fr = ln_ & 15, fq = ln_ >> 4;
        const int row0 = u.pm * 256 + wr * 64 + fr, col0 = u.pn * 256 + wc * 32 + 8 * fq;
#pragma unroll
        for (int ai = 0; ai < 2; ++ai) {
            v4u g[4][2]; f32x4 t0[4][2], t1[4][2];
#pragma unroll
            for (int m = 0; m < 4; ++m)
#pragma unroll
                for (int bj = 0; bj < 2; ++bj) { const size_t off = (size_t)(row0 + ai * 128 + m * 16) * DM + col0 + bj * 128;
                    g[m][bj] = *(const v4u*)(sg + off); t0[m][bj] = *(const f32x4*)(T1 + off); t1[m][bj] = *(const f32x4*)(T1 + off + 4); }
#pragma unroll
            for (int m = 0; m < 4; ++m)
#pragma unroll
                for (int bj = 0; bj < 2; ++bj) { const size_t off = (size_t)(row0 + ai * 128 + m * 16) * DM + col0 + bj * 128; const v4u q = g[m][bj]; const f32x4 a0 = t0[m][bj], a1 = t1[m][bj];
                    f32x4 v0 = acc[ai][bj][m][0], v1 = acc[ai][bj][m][1];
                    v0[0] = a0[0] + v0[0] * bflo(q.x); v0[1] = a0[1] + v0[1] * bfhi(q.x); v0[2] = a0[2] + v0[2] * bflo(q.y); v0[3] = a0[3] + v0[3] * bfhi(q.y);
                    v1[0] = a1[0] + v1[0] * bflo(q.z); v1[1] = a1[1] + v1[1] * bfhi(q.z); v1[2] = a1[2] + v1[2] * bflo(q.w); v1[3] = a1[3] + v1[3] * bfhi(q.w);
                    v4u w; w.x = cvtpk(v0[0], v0[1]); w.y = cvtpk(v0[2], v0[3]); w.z = cvtpk(v1[0], v1[1]); w.w = cvtpk(v1[2], v1[3]);
                    *(v4u*)(out + off) = w; }
            asm volatile("" ::: "memory");
        }
    }
};
struct EpiResid {
    static constexpr bool PERM = true, AFTER_DRAIN = false;
    const float* xin; float* xout; bf16_t* xb; float* ssqp_out;
    __device__ __forceinline__ void operator()(const f32x4 (&acc)[2][2][4][2], const Unit& u, int wr, int wc, int fr_, int fq_) const {
        (void)fr_; (void)fq_; const int ln_ = lane_id() & 63, fr = ln_ & 15, fq = ln_ >> 4;
        const int row0 = u.pm * 256 + wr * 64 + fr, col0 = u.pn * 256 + wc * 32 + 8 * fq;
#pragma unroll
        for (int ai = 0; ai < 2; ++ai) {
            f32x4 x0[4][2], x1[4][2];
#pragma unroll
            for (int m = 0; m < 4; ++m)
#pragma unroll
                for (int bj = 0; bj < 2; ++bj) { const size_t off = (size_t)(row0 + ai * 128 + m * 16) * DM + col0 + bj * 128; x0[m][bj] = *(const f32x4*)(xin + off); x1[m][bj] = *(const f32x4*)(xin + off + 4); }
#pragma unroll
            for (int m = 0; m < 4; ++m) {
                const int row = row0 + ai * 128 + m * 16; float ps = 0.f;
#pragma unroll
                for (int bj = 0; bj < 2; ++bj) {
                    const size_t off = (size_t)row * DM + col0 + bj * 128;
                    const f32x4 v0 = x0[m][bj] + acc[ai][bj][m][0], v1 = x1[m][bj] + acc[ai][bj][m][1];
                    *(f32x4*)(xout + off) = v0; *(f32x4*)(xout + off + 4) = v1;
                    ps += (v0[0] * v0[0] + v0[1] * v0[1]) + (v0[2] * v0[2] + v0[3] * v0[3]) + (v1[0] * v1[0] + v1[1] * v1[1]) + (v1[2] * v1[2] + v1[3] * v1[3]);
                    v4u w; w.x = cvtpk(v0[0], v0[1]); w.y = cvtpk(v0[2], v0[3]); w.z = cvtpk(v1[0], v1[1]); w.w = cvtpk(v1[2], v1[3]);
                    *(v4u*)(xb + off) = w;
                }
                ps += sw_xor<16>(ps); ps = add_xor32(ps);
                if (fq == 0) ssqp_out[(size_t)row * 32 + u.pn * 4 + wc] = ps;
            }
            asm volatile("" ::: "memory");
        }
    }
};
struct EpiMlpIn {
    static constexpr bool PERM = true, AFTER_DRAIN = false;
    const float* ssqp; bf16_t* out;
    __device__ __forceinline__ void operator()(const f32x4 (&acc)[2][2][4][2], const Unit& u, int wr, int wc, int fr_, int fq_) const {
        (void)fr_; (void)fq_; const int ln_ = lane_id() & 63, fr = ln_ & 15, fq = ln_ >> 4;
        const int row0 = u.pm * 256 + wr * 64 + fr, col0 = u.pn * 256 + wc * 32 + 8 * fq;
        float rs[2][4]; rows_rs(ssqp, row0, fq, rs);
#pragma unroll
        for (int ai = 0; ai < 2; ++ai)
#pragma unroll
            for (int m = 0; m < 4; ++m) {
                const int row = row0 + ai * 128 + m * 16; const float r = rs[ai][m];
#pragma unroll
                for (int bj = 0; bj < 2; ++bj) {
                    f32x4 v0 = acc[ai][bj][m][0] * r, v1 = acc[ai][bj][m][1] * r;
#pragma unroll
                    for (int e = 0; e < 4; ++e) { const float a = fmaxf(v0[e], 0.f), b = fmaxf(v1[e], 0.f); v0[e] = a * a; v1[e] = b * b; }
                    v4u w; w.x = cvtpk(v0[0], v0[1]); w.y = cvtpk(v0[2], v0[3]); w.z = cvtpk(v1[0], v1[1]); w.w = cvtpk(v1[2], v1[3]);
                    *(v4u*)(out + (size_t)row * DFF + col0 + bj * 128) = w;
                }
            }
    }
};

__device__ __forceinline__ float log2_gamma_calc(const float* logit) { const float x = *logit; return -log1pf(expf(-x)) * 1.4426950408889634f; }
__device__ __forceinline__ int srccol_win(int n) {
    const bool p = (n < 2048) || (n >= 6144 && n < 10240);
    return p ? ((n & ~127) + ((n & 127) >> 1) + ((n & 1) << 6)) : n;
}
constexpr int CP = 68;
struct ConvItem { const float* W; bf16_t* WT; const float* rscale; int K, N, rmask, k0, n0; float mulc; bool perm; };
__device__ __forceinline__ void conv_load(const ConvItem& d, f32x4 (&v)[16], int lane) {
    const int s4 = (lane & 15) * 4;
    const int col = d.perm ? ((d.n0 & ~127) + ((d.n0 & 127) >> 1) + (s4 & 31) + ((s4 >> 5) << 6)) : d.n0 + s4;
#pragma unroll
    for (int i = 0; i < 16; ++i) { const int kk = 4 * i + (lane >> 4); v[i] = __builtin_nontemporal_load((const f32x4*)(d.W + (size_t)(d.k0 + kk) * d.N + col)); }
}
__device__ __forceinline__ void conv_store(const ConvItem& d, const f32x4 (&v)[16], LAS float* scr, int lane) {
    const int s4 = (lane & 15) * 4;
#pragma unroll
    for (int i = 0; i < 16; ++i) { const int kk = 4 * i + (lane >> 4); const float sc = d.rscale ? d.rscale[(d.k0 + kk) & d.rmask] * d.mulc : 1.0f;
        *(LAS f32x4*)(scr + kk * CP + s4) = v[i] * sc; }
    LDS_WAIT(); asm volatile("" ::: "memory");
    const int c = lane & 7;
#pragma unroll
    for (int j = 0; j < 8; ++j) { const int r = (lane >> 3) + 8 * j, sidx = d.perm ? ((r >> 1) + 32 * (r & 1)) : r; const LAS float* q = scr + (8 * c) * CP + sidx;
        v4u o; o.x = pk2(q[0 * CP], q[1 * CP]); o.y = pk2(q[2 * CP], q[3 * CP]); o.z = pk2(q[4 * CP], q[5 * CP]); o.w = pk2(q[6 * CP], q[7 * CP]);
        *(v4u*)(d.WT + (size_t)(d.n0 + r) * d.K + d.k0 + 8 * c) = o; }
    LDS_WAIT(); asm volatile("" ::: "memory");
}
__device__ __forceinline__ void sincos_f32angle(float angf, float& c, float& s) {
    const double a = (double)angf;
    const double kq = __builtin_rint(a * 0.63661977236758134308);
    const double r = (a - kq * 1.5707963267948966192) - kq * 6.123233995736766e-17;
    const double r2 = r * r;
    double sp = -7.647163731819816e-13; sp = sp * r2 + 1.6059043836821613e-10; sp = sp * r2 - 2.5052108385441720e-08; sp = sp * r2 + 2.7557319223985893e-06;
    sp = sp * r2 - 1.9841269841269841e-04; sp = sp * r2 + 8.3333333333333333e-03; sp = sp * r2 - 1.6666666666666666e-01; const double sn = r + r * r2 * sp;
    double cp = 4.7794773323873853e-14; cp = cp * r2 - 1.1470745597729725e-11; cp = cp * r2 + 2.0876756987868099e-09; cp = cp * r2 - 2.7557319223985888e-07;
    cp = cp * r2 + 2.4801587301587302e-05; cp = cp * r2 - 1.3888888888888889e-03; cp = cp * r2 + 4.1666666666666664e-02; cp = cp * r2 - 0.5; const double cn = 1.0 + r2 * cp;
    const int q = ((int)kq) & 3;
    const double cc = (q == 0) ? cn : (q == 1) ? -sn : (q == 2) ? -cn : sn;
    const double ss = (q == 0) ? sn : (q == 1) ? cn : (q == 2) ? -sn : -cn;
    c = (float)cc; s = (float)ss;
}
#define CONV_DESC(d, it_) ConvItem d; { int r = (it_); \
    if (r < I_2) { d.W = w2s; d.K = DFF; d.N = DM; d.WT = (bf16_t*)(wl + W_2); d.rscale = nullptr; d.rmask = 0; d.mulc = 1.0f; d.perm = false; } \
    else if ((r -= I_2) < I_1) { d.W = w1s; d.K = DM; d.N = DFF; d.WT = (bf16_t*)(wl + W_1); d.rscale = g_mlp; d.rmask = DM - 1; d.mulc = 1.0f; d.perm = false; } \
    else if ((r -= I_1) < I_SQ) { d.W = wos; d.K = DM; d.N = DM; d.WT = (bf16_t*)(wl + W_OUT); d.rscale = nullptr; d.rmask = 0; d.mulc = 1.0f; d.perm = false; } \
    else if ((r -= I_SQ) < I_SQ) { d.W = wds; d.K = DM; d.N = DM; d.WT = (bf16_t*)(wl + W_DO); d.rscale = g_sub; d.rmask = DV2 - 1; d.mulc = oml; d.perm = false; } \
    else if ((r -= I_SQ) < I_SQ) { d.W = wrs; d.K = DM; d.N = DM; d.WT = (bf16_t*)(wl + W_RO); d.rscale = g_gn; d.rmask = DM - 1; d.mulc = 1.0f; d.perm = false; } \
    else { r -= I_SQ; d.W = wis; d.K = DM; d.N = INC; d.WT = (bf16_t*)(wl + W_IN); d.rscale = g_mix; d.rmask = DM - 1; d.mulc = 1.0f; d.perm = true; } \
    const int nblk = d.N / 64; d.k0 = 64 * (r / nblk); d.n0 = 64 * (r % nblk); \
    d.perm = d.perm && (d.n0 < 2048 || (d.n0 >= 6144 && d.n0 < 10240)); }
__device__ __forceinline__ void conv_layer(Frame& F, const Args& A, int l) {
    LAS float* scr = (LAS float*)(F.lds + F.wave * 17408);
    const int gw = blockIdx.x * NWAVES + F.wave, NGW = F.G * NWAVES, ln = lane_id() & 63;
    constexpr int I_IN = (DM / 64) * (INC / 64), I_SQ = (DM / 64) * (DM / 64), I_1 = (DM / 64) * (DFF / 64), I_2 = (DFF / 64) * (DM / 64);
    constexpr int I_LAYER = I_IN + 3 * I_SQ + I_1 + I_2;
    unsigned char* wl = F.ws + WS_W + (size_t)l * W_LAYER;
    const float* w2s = A.in[15] + (size_t)l * DFF * DM; const float* w1s = A.in[14] + (size_t)l * DM * DFF; const float* wos = A.in[12] + (size_t)l * DM * DM;
    const float* wds = A.in[11] + (size_t)l * DM * DM; const float* wrs = A.in[6] + (size_t)l * DM * DM; const float* wis = A.in[2] + (size_t)l * DM * INC;
    const float* g_mlp = A.in[13] + l * DM; const float* g_sub = A.in[10] + l * DV2; const float* g_gn = A.in[5] + l * DM; const float* g_mix = A.in[1] + l * DM; const float oml = A.om_lam_init[l];
    f32x4 va[16], vb[16]; int i0 = gw, i1 = gw + NGW;
    if (i0 < I_LAYER) { CONV_DESC(d, i0); conv_load(d, va, ln); }
    while (i0 < I_LAYER) {
        if (i1 < I_LAYER) { CONV_DESC(d, i1); conv_load(d, vb, ln); }
        { CONV_DESC(d, i0); conv_store(d, va, scr, ln); }
        i0 = i1 + NGW;
        if (i1 >= I_LAYER) break;
        if (i0 < I_LAYER) { CONV_DESC(d, i0); conv_load(d, va, ln); }
        { CONV_DESC(d, i1); conv_store(d, vb, scr, ln); }
        i1 = i0 + NGW;
    }
}
#undef CONV_DESC
__device__ __forceinline__ void p0_prologue(Frame& F, const Args& A) {
    const int gw = blockIdx.x * NWAVES + F.wave, NGW = F.G * NWAVES;
    conv_layer(F, A, 0);
    {
        const float* x = A.in[0]; bf16_t* xb = WSP(bf16_t, WS_XB); float* ssqp = WSP(float, WS_SSQP);
        for (int m = gw; m < L; m += NGW) {
            const f32x4* xr = (const f32x4*)(x + (size_t)m * DM) + F.lane; float s = 0.f;
            unsigned long long* o8 = (unsigned long long*)(xb + (size_t)m * DM) + F.lane;
#pragma unroll
            for (int j = 0; j < 8; ++j) { const f32x4 v = xr[64 * j]; s += (v[0] * v[0] + v[1] * v[1]) + (v[2] * v[2] + v[3] * v[3]);
                o8[64 * j] = (unsigned long long)pk2(v[0], v[1]) | ((unsigned long long)pk2(v[2], v[3]) << 32); }
            s = wave_sum(s);
            if (F.lane < 32) ssqp[(size_t)m * 32 + F.lane] = F.lane == 0 ? s : 0.f;
        }
    }
    {
        float* cs = WSP(float, WS_ROPE);
        for (int p = gw; p < L; p += NGW) { const float ang = (float)p * A.inv[F.lane]; float c, s; sincos_f32angle(ang, c, s);
            *(float2*)(cs + ((size_t)p * 64 + F.lane) * 2) = make_float2(c, s); }
    }
    if (blockIdx.x == 0 && F.wave < NLAYER) {
        const int l = F.wave; const float* lp = A.in[9] + l * 4 * HD; const float* qw = A.in[7] + l * HD; const float* kw = A.in[8] + l * HD;
        float s01 = 0.f, s23 = 0.f, mq = 0.f, mk = 0.f;
        for (int i = F.lane; i < HD; i += 64) { s01 += lp[i] * lp[HD + i]; s23 += lp[2 * HD + i] * lp[3 * HD + i]; mq = fmaxf(mq, fabsf(qw[i])); mk = fmaxf(mk, fabsf(kw[i])); }
        s01 = wave_sum(s01); s23 = wave_sum(s23);
        mq = wave_max(mq); mk = wave_max(mk);
        if (F.lane < 2 * NH) { const int dir = F.lane >> 3, h = F.lane & 7; WSP(float, WS_CONST)[8 + (l * 2 + dir) * NH + h] = log2_gamma_calc((dir ? A.in[4] : A.in[3]) + l * NH + h); }
        if (F.lane == 0) { float* cst = WSP(float, WS_CONST); cst[l] = expf(s01) - expf(s23) + A.lam_init[l];
            cst[4 + l] = 128.0f * mq * mk * 0.12751743082459868f; }
    }
}

constexpr int TP = 136;
#define LG2G(F, layer, dir, h) (WSP(float, WS_CONST)[8 + ((layer) * 2 + (dir)) * NH + (h)])
__device__ __forceinline__ void phase_r1(Frame& F, const Args& A, int layer) {
    LAS bf16_t* KtF = (LAS bf16_t*)F.lds; LAS bf16_t* KtB = KtF + 128 * TP; LAS bf16_t* Vt = KtB + 128 * TP;
    const int wid = F.wave;
    const bf16_t* KR = WSP(bf16_t, WS_KR); const bf16_t* VR = WSP(bf16_t, WS_VR);
    for (int u = blockIdx.x; u < NCH * NH; u += F.G) {
        const int cc = u >> 3, h = u & 7;
        const float lgf = LG2G(F, layer, 0, h), lgb = LG2G(F, layer, 1, h);
        const int tid_o = (F.wave * 64 + (lane_id() & 63)), r32 = tid_o & 31, hi = (tid_o >> 5) & 1;
        __syncthreads();
#pragma unroll
        for (int i = 0; i < 4; ++i) { const int q = tid_o + 512 * i, pos = q & 127, d0 = (q >> 7) * 8;
            const v4u v = *(const v4u*)(KR + (size_t)(cc * CH + pos) * 1024 + h * HD + d0);
            const float wf = __builtin_amdgcn_exp2f((float)(127 - pos) * lgf), wb = __builtin_amdgcn_exp2f((float)pos * lgb);
            const float e[8] = {bflo(v.x), bfhi(v.x), bflo(v.y), bfhi(v.y), bflo(v.z), bfhi(v.z), bflo(v.w), bfhi(v.w)};
#pragma unroll
            for (int k = 0; k < 8; ++k) { KtF[(d0 + k) * TP + pos] = (bf16_t)f2bf(e[k] * wf); KtB[(d0 + k) * TP + pos] = (bf16_t)f2bf(e[k] * wb); } }
#pragma unroll
        for (int i = 0; i < 8; ++i) { const int q = tid_o + 512 * i, pos = q & 127, d0 = (q >> 7) * 8;
            const v4u v = *(const v4u*)(VR + (size_t)(cc * CH + pos) * DM + h * DV2 + d0);
            const unsigned w[4] = {v.x, v.y, v.z, v.w};
#pragma unroll
            for (int k = 0; k < 4; ++k) { Vt[(d0 + 2 * k) * TP + pos] = (bf16_t)(w[k] & 0xffffu); Vt[(d0 + 2 * k + 1) * TP + pos] = (bf16_t)(w[k] >> 16); } }
        __syncthreads();
#pragma unroll
        for (int dir = 0; dir < 2; ++dir) {
            const LAS bf16_t* Kt = dir ? KtB : KtF;
            f32x16 acc[4];
#pragma unroll
            for (int n = 0; n < 4; ++n)
#pragma unroll
                for (int r = 0; r < 16; ++r) acc[n][r] = 0.f;
#pragma unroll 2
            for (int ks = 0; ks < 8; ++ks) {
                const bf16x8 a = *(const LAS bf16x8*)(Vt + (32 * wid + r32) * TP + ks * 16 + hi * 8);
#pragma unroll
                for (int n = 0; n < 4; ++n) { const bf16x8 b = *(const LAS bf16x8*)(Kt + (32 * n + r32) * TP + ks * 16 + hi * 8);
                    acc[n] = __builtin_amdgcn_mfma_f32_32x32x16_bf16(a, b, acc[n], 0, 0, 0); }
            }
            bf16_t* out = (dir ? WSP(bf16_t, WS_KVB) : WSP(bf16_t, WS_KVF)) + ((size_t)(cc * NH + h) * DV2 + 32 * wid) * HD;
#pragma unroll
            for (int n = 0; n < 4; ++n)
#pragma unroll
                for (int r = 0; r < 16; ++r) out[crow(r, hi) * HD + 32 * n + r32] = (bf16_t)f2bf(acc[n][r]);
        }
    }
}
__device__ __forceinline__ void phase_r2(Frame& F, const Args& A, int layer) {
    constexpr int PER_DIR = NH * DV2 * HD / 4;
    constexpr size_t CSTR = (size_t)NH * DV2 * HD;
    for (int gid = blockIdx.x * 512 + (F.wave * 64 + (lane_id() & 63)); gid < 2 * PER_DIR; gid += F.G * 512) {
        const int dir = gid >= PER_DIR, e4 = gid - dir * PER_DIR, h = e4 / (DV2 * HD / 4);
        const float lg = LG2G(F, layer, dir, h), Gm = __builtin_amdgcn_exp2f(128.0f * lg);
        const bf16_t* kv = (dir ? WSP(bf16_t, WS_KVB) : WSP(bf16_t, WS_KVF)) + (size_t)e4 * 4;
        bf16_t* st = (dir ? WSP(bf16_t, WS_STB) : WSP(bf16_t, WS_STF)) + (size_t)e4 * 4;
        f32x4 s = {0.f, 0.f, 0.f, 0.f};
#pragma unroll 32
        for (int i = 0; i < NCH; ++i) { const int c = dir ? (NCH - 1 - i) : i;
            const v2u vw = *(const v2u*)(kv + (size_t)c * CSTR); const f32x4 v = {bflo(vw.x), bfhi(vw.x), bflo(vw.y), bfhi(vw.y)};
            v2u o; o.x = cvtpk(s[0], s[1]); o.y = cvtpk(s[2], s[3]); *(v2u*)(st + (size_t)c * CSTR) = o;
            s = s * Gm + v; }
    }
}
__device__ __forceinline__ bf16x8 scale_bf8(bf16x8 q, float a) {
    v4u w = __builtin_bit_cast(v4u, q), o;
    o.x = cvtpk(bflo(w.x) * a, bfhi(w.x) * a); o.y = cvtpk(bflo(w.y) * a, bfhi(w.y) * a); o.z = cvtpk(bflo(w.z) * a, bfhi(w.z) * a); o.w = cvtpk(bflo(w.w) * a, bfhi(w.w) * a);
    return __builtin_bit_cast(bf16x8, o);
}
__device__ __forceinline__ void phase_r3(Frame& F, const Args& A, int layer) {
    LAS bf16_t* Ks = (LAS bf16_t*)F.lds; LAS bf16_t* Vt = Ks + 128 * TP;
    const int wid = F.wave;
    const bf16_t* QR = WSP(bf16_t, WS_QR); const bf16_t* KR = WSP(bf16_t, WS_KR); const bf16_t* VR = WSP(bf16_t, WS_VR); const bf16_t* GR = WSP(bf16_t, WS_GR);
    bf16_t* UR = WSP(bf16_t, WS_URET);
    for (int u = blockIdx.x; u < NCH * NH; u += F.G) {
        const int cc = u >> 3, h = u & 7;
        const int tid_o = (F.wave * 64 + (lane_id() & 63)), lane_o = tid_o & 63, c16 = lane_o & 15, g = lane_o >> 4;
        const float lgf = LG2G(F, layer, 0, h), lgb = LG2G(F, layer, 1, h);
        __syncthreads();
#pragma unroll
        for (int i = 0; i < 4; ++i) { const int q = tid_o + 512 * i, row = q >> 4, ch = q & 15;
            *(LAS v4u*)(Ks + row * TP + ch * 8) = *(const v4u*)(KR + (size_t)(cc * CH + row) * 1024 + h * HD + ch * 8); }
#pragma unroll
        for (int i = 0; i < 8; ++i) { const int q = tid_o + 512 * i, pos = q & 127, d0 = (q >> 7) * 8;
            const v4u v = *(const v4u*)(VR + (size_t)(cc * CH + pos) * DM + h * DV2 + d0);
            const unsigned w[4] = {v.x, v.y, v.z, v.w};
#pragma unroll
            for (int k = 0; k < 4; ++k) { Vt[(d0 + 2 * k) * TP + pos] = (bf16_t)(w[k] & 0xffffu); Vt[(d0 + 2 * k + 1) * TP + pos] = (bf16_t)(w[k] >> 16); } }
        __syncthreads();
        const int pos_i = 16 * wid + c16; const size_t gpos = (size_t)cc * CH + pos_i;
        bf16x8 qf[4];
#pragma unroll
        for (int s = 0; s < 4; ++s) qf[s] = *(const bf16x8*)(QR + gpos * 1024 + h * HD + 32 * s + 8 * g);
        f32x4 st[8];
#pragma unroll
        for (int b = 0; b < 8; ++b) { st[b] = (f32x4){0.f, 0.f, 0.f, 0.f};
#pragma unroll
            for (int s = 0; s < 4; ++s) { const bf16x8 a = *(const LAS bf16x8*)(Ks + (16 * b + c16) * TP + 32 * s + 8 * g);
                st[b] = __builtin_amdgcn_mfma_f32_16x16x32_bf16(a, qf[s], st[b], 0, 0, 0); } }
#pragma unroll
        for (int b = 0; b < 8; ++b)
#pragma unroll
            for (int r = 0; r < 4; ++r) { const int d = pos_i - (16 * b + 4 * g + r);
                const float m = d > 0 ? __builtin_amdgcn_exp2f((float)d * lgf) : (d < 0 ? __builtin_amdgcn_exp2f((float)(-d) * lgb) : 2.0f);
                st[b][r] *= m; }
        f32x4 R[16];
#pragma unroll
        for (int n = 0; n < 16; ++n) R[n] = (f32x4){0.f, 0.f, 0.f, 0.f};
#pragma unroll
        for (int s2 = 0; s2 < 4; ++s2) {
            v4u pw; pw.x = cvtpk(st[2 * s2][0], st[2 * s2][1]); pw.y = cvtpk(st[2 * s2][2], st[2 * s2][3]); pw.z = cvtpk(st[2 * s2 + 1][0], st[2 * s2 + 1][1]); pw.w = cvtpk(st[2 * s2 + 1][2], st[2 * s2 + 1][3]);
            const bf16x8 pa = __builtin_bit_cast(bf16x8, pw);
#pragma unroll
            for (int n = 0; n < 16; ++n) {
                const v2u lo = *(const LAS v2u*)(Vt + (16 * n + c16) * TP + 32 * s2 + 4 * g), hi4 = *(const LAS v2u*)(Vt + (16 * n + c16) * TP + 32 * s2 + 16 + 4 * g);
                v4u bw; bw.x = lo.x; bw.y = lo.y; bw.z = hi4.x; bw.w = hi4.y;
                R[n] = __builtin_amdgcn_mfma_f32_16x16x32_bf16(pa, __builtin_bit_cast(bf16x8, bw), R[n], 0, 0, 0);
            }
            asm volatile("" ::: "memory");
        }
#pragma unroll
        for (int dir = 0; dir < 2; ++dir) {
            const float asc = dir ? __builtin_amdgcn_exp2f((float)(CH - pos_i) * lgb) : __builtin_amdgcn_exp2f((float)(pos_i + 1) * lgf);
            const bf16_t* ST = (dir ? WSP(bf16_t, WS_STB) : WSP(bf16_t, WS_STF)) + (size_t)(cc * NH + h) * DV2 * HD;
#pragma unroll
            for (int s = 0; s < 4; ++s) { const bf16x8 qs = scale_bf8(qf[s], asc);
#pragma unroll
                for (int n = 0; n < 16; ++n) { const bf16x8 b = *(const bf16x8*)(ST + (size_t)(16 * n + c16) * HD + 32 * s + 8 * g);
                    R[n] = __builtin_amdgcn_mfma_f32_16x16x32_bf16(qs, b, R[n], 0, 0, 0); }
                asm volatile("" ::: "memory"); }
        }
#pragma unroll
        for (int r = 0; r < 4; ++r) {
            float s = 0.f;
#pragma unroll
            for (int n = 0; n < 16; ++n) s += R[n][r];
            s = sum16(s);
            const float mean = s * (1.0f / DV2); float q = 0.f;
#pragma unroll
            for (int n = 0; n < 16; ++n) { const float d = R[n][r] - mean; q += d * d; }
            q = sum16(q);
            const float rstd = __builtin_amdgcn_rsqf(q * (1.0f / DV2) + GN_EPS);
            int c16o = c16; asm volatile("" : "+v"(c16o) : "v"(rstd));
            const size_t ro = ((size_t)cc * CH + 16 * wid + 4 * g + r) * DM + h * DV2 + (c16o & 15);
            const GAS bf16_t* gp = (const GAS bf16_t*)(GR + ro); GAS bf16_t* up = (GAS bf16_t*)(UR + ro);
#pragma unroll
            for (int n = 0; n < 16; ++n) up[16 * n] = (bf16_t)f2bf((R[n][r] - mean) * rstd * bf2f(gp[16 * n]));
            asm volatile("" ::: "memory");
        }
    }
}

constexpr int AK_BYTES = 16384, AV_BYTES = 32768, AV_OFF = 2 * AK_BYTES, ASCR_OFF = AV_OFF + 3 * AV_BYTES;
#define KSWZ(row, colB) ((row) * 256 + ((colB) ^ (((row) & 15) << 4)))
__device__ __forceinline__ int v_rd_base(int lane) { return ((lane & 3) << 3) | (((lane >> 2) & 3) << 6) | (((lane >> 4) & 1) << 5) | (((lane >> 5) & 1) << 8); }
constexpr int v_rd_off(int d0, int ks, int half) { return d0 * 512 + ks * 8192 + half * 4096; }
template <int OFF> __device__ __forceinline__ s16x4 tr_read(int vb) {
    s16x4 r; asm volatile("ds_read_b64_tr_b16 %0, %1 offset:%2" : "=&v"(r) : "v"(vb), "i"(OFF) : "memory"); return r;
}
struct VFrag { s16x4 l0, h0, l1, h1, l2, h2, l3, h3; };
template <int D0> __device__ __forceinline__ void pv_reads(VFrag& f, int vb) {
    f.l0 = tr_read<v_rd_off(D0, 0, 0)>(vb); f.h0 = tr_read<v_rd_off(D0, 0, 1)>(vb); f.l1 = tr_read<v_rd_off(D0, 1, 0)>(vb); f.h1 = tr_read<v_rd_off(D0, 1, 1)>(vb);
    f.l2 = tr_read<v_rd_off(D0, 2, 0)>(vb); f.h2 = tr_read<v_rd_off(D0, 2, 1)>(vb); f.l3 = tr_read<v_rd_off(D0, 3, 0)>(vb); f.h3 = tr_read<v_rd_off(D0, 3, 1)>(vb);
}
__device__ __forceinline__ void pv_mma(f32x16& od, const VFrag& f, bf16x8 pa0, bf16x8 pa1, bf16x8 pa2, bf16x8 pa3) {
#define PKV(Lx, Hx) (bf16x8){Lx[0], Lx[1], Lx[2], Lx[3], Hx[0], Hx[1], Hx[2], Hx[3]}
    od = __builtin_amdgcn_mfma_f32_32x32x16_bf16(pa0, PKV(f.l0, f.h0), od, 0, 0, 0);
    od = __builtin_amdgcn_mfma_f32_32x32x16_bf16(pa1, PKV(f.l1, f.h1), od, 0, 0, 0);
    od = __builtin_amdgcn_mfma_f32_32x32x16_bf16(pa2, PKV(f.l2, f.h2), od, 0, 0, 0);
    od = __builtin_amdgcn_mfma_f32_32x32x16_bf16(pa3, PKV(f.l3, f.h3), od, 0, 0, 0);
#undef PKV
}
#define PV_WAIT8() do { asm volatile("s_waitcnt lgkmcnt(8)" ::: "memory"); SBAR(); } while (0)
#define PV_WAIT0() do { asm volatile("s_waitcnt lgkmcnt(0)" ::: "memory"); SBAR(); } while (0)
template <class DmaF> __device__ __forceinline__ void pv_tile(f32x16 (&o)[8], int vb, bf16x8 pa0, bf16x8 pa1, bf16x8 pa2, bf16x8 pa3, DmaF dma) {
    VFrag fa, fb;
    pv_reads<0>(fa, vb);
    pv_reads<1>(fb, vb); PV_WAIT8(); pv_mma(o[0], fa, pa0, pa1, pa2, pa3);
    pv_reads<2>(fa, vb); PV_WAIT8(); pv_mma(o[1], fb, pa0, pa1, pa2, pa3);
    dma();
    pv_reads<3>(fb, vb); PV_WAIT8(); pv_mma(o[2], fa, pa0, pa1, pa2, pa3);
    pv_reads<4>(fa, vb); PV_WAIT8(); pv_mma(o[3], fb, pa0, pa1, pa2, pa3);
    pv_reads<5>(fb, vb); PV_WAIT8(); pv_mma(o[4], fa, pa0, pa1, pa2, pa3);
    pv_reads<6>(fa, vb); PV_WAIT8(); pv_mma(o[5], fb, pa0, pa1, pa2, pa3);
    pv_reads<7>(fb, vb); PV_WAIT8(); pv_mma(o[6], fa, pa0, pa1, pa2, pa3);
    PV_WAIT0(); pv_mma(o[7], fb, pa0, pa1, pa2, pa3);
}
__device__ __forceinline__ void phase_attn(Frame& F, const Args& A, int layer) {
    const int lane = (lane_id() & 63), wid = F.wave, r32 = lane & 31, hi = lane >> 5;
    LAS unsigned char* Kl = F.lds; LAS unsigned char* Vl = F.lds + AV_OFF;
    LAS float* wsf = (LAS float*)(F.lds + ASCR_OFF) + wid * 64;
    const float lam = WSP(float, WS_CONST)[layer], Bs = WSP(float, WS_CONST)[4 + layer];
    const bf16_t* DQ = WSP(bf16_t, WS_DQ); const bf16_t* DK = WSP(bf16_t, WS_DK); const bf16_t* DV = WSP(bf16_t, WS_DV); bf16_t* OD = WSP(bf16_t, WS_ODIFF);
    const int vb0 = (int)(uintptr_t)Vl + v_rd_base(lane);
    for (int u = blockIdx.x; u < NH * (L / 256); u += F.G) {
        const int h = u & 7, qb = u >> 3;
        const int ld_ = opaque(lane) & 63; unsigned koff[2], voff[4];
#pragma unroll
        for (int i = 0; i < 2; ++i) { const int p = 2 * wid + i, row = 4 * p + (ld_ >> 4), c = (ld_ & 15) ^ (row & 15); koff[i] = (unsigned)(row * DM + c * 8) * 2u; }
#pragma unroll
        for (int i = 0; i < 4; ++i) { const int p = 4 * wid + i, s = 2 * p + (ld_ >> 5), kg = s >> 3, cb = s & 7, rin = (ld_ & 31) >> 2, kk = kg * 8 + rin;
        const int k = (kk & ~0xC) | ((kk & 4) << 1) | ((kk & 8) >> 1), c = cb * 32 + (ld_ & 3) * 8; voff[i] = (unsigned)(k * DM + c) * 2u; }
        float* scratch = WSP(float, WS_ATT) + ((size_t)(u * NWAVES + wid) * 128) * 64 + lane;
#pragma unroll 1
        for (int t = 0; t < 2; ++t) {
            int lq = lane; asm volatile("" : "+v"(lq));
            const bf16_t* Qp = DQ + (size_t)(qb * 256 + wid * 32 + (lq & 31)) * DM + (h * 2 + t) * HD + (lq >> 5) * 8;
            bf16x8 qr[8];
#pragma unroll
            for (int d0 = 0; d0 < 8; ++d0) qr[d0] = *(const bf16x8*)(Qp + d0 * 16);
            const char* Kg = (const char*)(DK + (h * 2 + t) * HD); const char* Vg = (const char*)(DV + h * DV2);
#define ATT_DMA_K(j, b) do { const char* kb_ = Kg + (size_t)(j) * (64 * DM * 2); \
            _Pragma("unroll") for (int i_ = 0; i_ < 2; ++i_) { unsigned ko_ = koff[i_]; asm volatile("" : "+v"(ko_)); __builtin_amdgcn_global_load_lds((const unsigned*)(kb_ + ko_), (LAS unsigned*)(Kl + (b) * AK_BYTES + (2 * wid + i_) * 1024), 16, 0, 0); } } while (0)
#define ATT_DMA_V(j, b) do { const char* vb_ = Vg + (size_t)(j) * (64 * DM * 2); \
            _Pragma("unroll") for (int i_ = 0; i_ < 4; ++i_) { unsigned vo_ = voff[i_]; asm volatile("" : "+v"(vo_)); __builtin_amdgcn_global_load_lds((const unsigned*)(vb_ + vo_), (LAS unsigned*)(Vl + (b) * AV_BYTES + (4 * wid + i_) * 1024), 16, 0, 0); } } while (0)
#define ATT_HSYNC(N) do { asm volatile("s_waitcnt vmcnt(" #N ")" ::: "memory"); asm volatile("s_waitcnt lgkmcnt(0)" ::: "memory"); __builtin_amdgcn_s_barrier(); asm volatile("" ::: "memory"); } while (0)
            constexpr float C2 = 0.12751743082459868f;
#define ATT_QKSM(b, DMA_STMT) do { const LAS unsigned char* Ks = Kl + (b) * AK_BYTES; f32x16 p0, p1; \
            _Pragma("unroll") for (int r = 0; r < 16; ++r) { p0[r] = 0.f; p1[r] = 0.f; } \
            __builtin_amdgcn_s_setprio(2); \
            _Pragma("unroll") for (int d0 = 0; d0 < 8; ++d0) { const int cbb = (d0 * 16 + hi * 8) * 2; \
                const bf16x8 b0 = *(const LAS bf16x8*)(Ks + KSWZ(r32, cbb)); const bf16x8 b1 = *(const LAS bf16x8*)(Ks + KSWZ(32 + r32, cbb)); \
                p0 = __builtin_amdgcn_mfma_f32_32x32x16_bf16(b0, qr[d0], p0, 0, 0, 0); p1 = __builtin_amdgcn_mfma_f32_32x32x16_bf16(b1, qr[d0], p1, 0, 0, 0); } \
            __builtin_amdgcn_s_setprio(0); DMA_STMT; \
            float ps = 0.f; \
            _Pragma("unroll") for (int r = 0; r < 16; ++r) { p0[r] = __builtin_amdgcn_exp2f(fmaf(p0[r], C2, -Bs)); p1[r] = __builtin_amdgcn_exp2f(fmaf(p1[r], C2, -Bs)); ps += p0[r] + p1[r]; } \
            l_reg += ps; PK4(p0, 0, pa0); PK4(p0, 8, pa1); PK4(p1, 0, pa2); PK4(p1, 8, pa3); } while (0)
#define PK4(P, BASE, OUT) do { unsigned a0 = cvtpk(P[BASE + 0], P[BASE + 1]), a1 = cvtpk(P[BASE + 2], P[BASE + 3]);   \
    unsigned b0_ = cvtpk(P[BASE + 4], P[BASE + 5]), b1_ = cvtpk(P[BASE + 6], P[BASE + 7]);                              \
    auto r0 = __builtin_amdgcn_permlane32_swap(a0, b0_, false, false); auto r1 = __builtin_amdgcn_permlane32_swap(a1, b1_, false, false); \
    v4u w_ = {r0[0], r1[0], r0[1], r1[1]}; OUT = __builtin_bit_cast(bf16x8, w_); } while (0)
#define ATT_PV(b, DMA_STMT) do { const int vb_ = (int)(uintptr_t)Vl + v_rd_base(lane_id() & 63) + (b) * AV_BYTES; VFrag fa_, fb_; \
            pv_reads<0>(fa_, vb_); \
            pv_reads<1>(fb_, vb_); PV_WAIT8(); pv_mma(o[0], fa_, pa0, pa1, pa2, pa3); \
            pv_reads<2>(fa_, vb_); PV_WAIT8(); pv_mma(o[1], fb_, pa0, pa1, pa2, pa3); \
            DMA_STMT; \
            pv_reads<3>(fb_, vb_); PV_WAIT8(); pv_mma(o[2], fa_, pa0, pa1, pa2, pa3); \
            pv_reads<4>(fa_, vb_); PV_WAIT8(); pv_mma(o[3], fb_, pa0, pa1, pa2, pa3); \
            pv_reads<5>(fb_, vb_); PV_WAIT8(); pv_mma(o[4], fa_, pa0, pa1, pa2, pa3); \
            pv_reads<6>(fa_, vb_); PV_WAIT8(); pv_mma(o[5], fb_, pa0, pa1, pa2, pa3); \
            pv_reads<7>(fb_, vb_); PV_WAIT8(); pv_mma(o[6], fa_, pa0, pa1, pa2, pa3); \
            PV_WAIT0(); pv_mma(o[7], fb_, pa0, pa1, pa2, pa3); } while (0)
            f32x16 o[8];
#pragma unroll
            for (int d = 0; d < 8; ++d)
#pragma unroll
                for (int r = 0; r < 16; ++r) o[d][r] = 0.f;
            float l_reg = 0.f; bf16x8 pa0, pa1, pa2, pa3;
            constexpr int NT = L / 64;
#define ATT_TSYNC() do { asm volatile("s_waitcnt vmcnt(0)" ::: "memory"); asm volatile("s_waitcnt lgkmcnt(0)" ::: "memory"); __builtin_amdgcn_s_barrier(); asm volatile("" ::: "memory"); } while (0)
            __syncthreads();
            ATT_DMA_K(0, 0); ATT_DMA_V(0, 0); VM_WAIT(); __syncthreads();
            if (wid < 4) {
                int v3 = 0;
#pragma unroll 1
                for (int j = 0; j < NT; ++j) { const int b = j & 1, vn = v3 == 2 ? 0 : v3 + 1, jn = j + 1 < NT ? j + 1 : NT - 1;
                    ATT_QKSM(b, ATT_DMA_K(jn, b ^ 1)); SBAR(); asm volatile("" ::: "memory");
                    ATT_PV(v3, ATT_DMA_V(jn, vn));
                    ATT_TSYNC(); v3 = vn; }
            } else {
                int v3 = 0;
#pragma unroll 1
                for (int j = 0; j < NT; ++j) { const int b = j & 1, vn = v3 == 2 ? 0 : v3 + 1, vp = v3 == 0 ? 2 : v3 - 1, jn = j + 1 < NT ? j + 1 : NT - 1;
                    ATT_DMA_V(jn, vn);
                    if (j > 0) ATT_PV(vp, (void)0);
                    SBAR(); asm volatile("" ::: "memory");
                    ATT_QKSM(b, ATT_DMA_K(jn, b ^ 1));
                    ATT_TSYNC(); v3 = vn; }
                ATT_PV((NT - 1) % 3, (void)0); asm volatile("s_waitcnt lgkmcnt(0)" ::: "memory");
            }
#undef ATT_TSYNC
#undef ATT_DMA_K
#undef ATT_DMA_V
#undef ATT_HSYNC
#undef ATT_QKSM
#undef ATT_PV
#undef PK4
            int le = lane; asm volatile("" : "+v"(le));
            const int r32e = le & 31, hie = le >> 5;
            const float lt = add_xor32(l_reg);
            if (hie == 0) wsf[r32e] = lt;
            LDS_WAIT();
            float rli[16];
#pragma unroll
            for (int r = 0; r < 16; ++r) rli[r] = __builtin_amdgcn_rcpf(wsf[crow(r, hie)]);
            LDS_WAIT();
            GAS float* sp = (GAS float*)(WSP(float, WS_ATT) + ((size_t)(u * NWAVES + wid) * 128) * 64 + le);
            if (t == 0) {
#pragma unroll
                for (int d = 0; d < 8; ++d) {
#pragma unroll
                    for (int r = 0; r < 16; ++r) sp[(d * 16 + r) * 64] = o[d][r] * rli[r];
                    asm volatile("" ::: "memory"); }
            } else {
                float ss[16];
#pragma unroll
                for (int r = 0; r < 16; ++r) ss[r] = 0.f;
#pragma unroll
                for (int d = 0; d < 8; ++d) {
#pragma unroll
                    for (int r = 0; r < 16; ++r) { const float v = sp[(d * 16 + r) * 64] - lam * (o[d][r] * rli[r]); ss[r] += v * v; sp[(d * 16 + r) * 64] = v; }
                    asm volatile("" ::: "memory"); }
#pragma unroll
                for (int r = 0; r < 16; ++r) { float s = sum32(ss[r]);
                    ss[r] = __builtin_amdgcn_rsqf(s * (1.0f / DV2) + NORM_EPS); }
                GAS bf16_t* op = (GAS bf16_t*)(OD + (size_t)(qb * 256 + wid * 32 + 4 * hie) * DM + h * DV2 + r32e);
#pragma unroll
                for (int r = 0; r < 16; ++r) {
                    GAS bf16_t* opr = op + ((r & 3) + 8 * (r >> 2)) * DM;
#pragma unroll
                    for (int d = 0; d < 8; ++d) opr[d * 32] = (bf16_t)f2bf(sp[(d * 16 + r) * 64] * ss[r]);
                    asm volatile("" ::: "memory"); }
            }
        }
    }
}

constexpr int PH_PER_LAYER = 8, N_PHASES = 1 + NLAYER * PH_PER_LAYER;
__global__ void __launch_bounds__(NWAVES * 64, 2) fwd(Args args) {
    extern __shared__ __attribute__((aligned(16))) unsigned char lds[];
    Frame F;
    F.lds = (LAS unsigned char*)lds; F.ws = args.ws;
    F.wave = __builtin_amdgcn_readfirstlane((int)threadIdx.x >> 6); F.lane = lane_id() & 63; F.tid = F.wave * 64 + F.lane; F.G = gridDim.x;
    volatile LAS unsigned* MISC = (volatile LAS unsigned*)(F.lds + MISC_OFF);
    if (F.tid < 32) MISC[F.tid] = 0u;
    __syncthreads();
    const int lo = args.ph_lo, hi = args.ph_hi;
    unsigned* barw = (unsigned*)(F.ws + WS_CTL) + CW_BAR;
    XcdBarrier bar; bar.bar = barw; bar.x = 0; bar.st = MISC + 8;
    if (hi - lo > 1) bar = xcd_barrier_post(barw, MISC + 8, F.wave == 0 && lane_id() == 0);
#define IN(k) (lo <= (k) && (k) < hi)
#define SEAM(k) do { if (IN(k) && IN((k) + 1)) { XcdBarrier b_ = bar; unsigned* bw_ = b_.bar; asm volatile("" : "+s"(bw_)); b_.bar = bw_; xcd_barrier(b_, F.wave == 0 && lane_id() == 0); } } while (0)
    if (IN(0)) p0_prologue(F, args);
    SEAM(0);
#pragma unroll 1
    for (int l = 0; l < NLAYER; ++l) {
        const int pb = 1 + l * PH_PER_LAYER;
        const Args& A = args;
        { unsigned char* w_ = A.ws; asm volatile("" : "+s"(w_)); F.ws = w_; int t_ = lane_id(); asm volatile("" : "+v"(t_)); F.lane = t_ & 63; F.tid = F.wave * 64 + F.lane; }
        unsigned char* wl = F.ws + WS_W + (size_t)l * W_LAYER;
        float* ssqp = WSP(float, WS_SSQP);
        if (IN(pb + 0)) {
            pg8::Gemm g{WSP(bf16_t, WS_XB), (const bf16_t*)(wl + W_IN), L, INC, DM}; pg8::StaticOrder S; S.init(L, INC, F.G, (int)blockIdx.x);
            EpiInProj E{ssqp + (size_t)(2 * l) * L * 32, WSP(float, WS_ROPE), F.ws, (LAS float*)(F.lds + 131072), A.in[7] + l * HD, A.in[8] + l * HD};
            pg8::gemm_phase<EpiInProj, pg8::StaticOrder, true, true>(F.lds, g, S, E, F.wave);
        }
        SEAM(pb + 0);
        if (IN(pb + 1)) phase_r1(F, A, l);
        SEAM(pb + 1);
        if (IN(pb + 2)) phase_r2(F, A, l);
        SEAM(pb + 2);
        if (IN(pb + 3)) phase_r3(F, A, l);
        if (IN(pb + 3)) phase_attn(F, A, l);
        SEAM(pb + 3);
        if (IN(pb + 4)) {
            { pg8::Gemm g{WSP(bf16_t, WS_URET), (const bf16_t*)(wl + W_RO), L, DM, DM}; pg8::StaticOrder S; S.init(L, DM, F.G, (int)blockIdx.x);
              EpiGateA E{WSP(bf16_t, WS_SGR), WSP(float, WS_T1)};
              pg8::gemm_phase<EpiGateA, pg8::StaticOrder, true, true>(F.lds, g, S, E, F.wave); }
            VM_WAIT(); __syncthreads();
            { pg8::Gemm g{WSP(bf16_t, WS_ODIFF), (const bf16_t*)(wl + W_DO), L, DM, DM}; pg8::StaticOrder S; S.init(L, DM, F.G, (int)blockIdx.x);
              EpiGateB E{WSP(bf16_t, WS_SGD), WSP(float, WS_T1), WSP(bf16_t, WS_MERGED)};
              pg8::gemm_phase<EpiGateB, pg8::StaticOrder, true, true>(F.lds, g, S, E, F.wave); }
        }
        SEAM(pb + 4);
        if (IN(pb + 5)) {
            pg8::Gemm g{WSP(bf16_t, WS_MERGED), (const bf16_t*)(wl + W_OUT), L, DM, DM}; pg8::StaticOrder S; S.init(L, DM, F.G, (int)blockIdx.x);
            EpiResid E{l == 0 ? A.in[0] : (const float*)A.out, A.out, WSP(bf16_t, WS_XB), ssqp + (size_t)(2 * l + 1) * L * 32};
            pg8::gemm_phase<EpiResid, pg8::StaticOrder, true, true>(F.lds, g, S, E, F.wave);
        }
        SEAM(pb + 5);
        if (IN(pb + 6)) {
            pg8::Gemm g{WSP(bf16_t, WS_XB), (const bf16_t*)(wl + W_1), L, DFF, DM}; pg8::StaticOrder S; S.init(L, DFF, F.G, (int)blockIdx.x);
            EpiMlpIn E{ssqp + (size_t)(2 * l + 1) * L * 32, WSP(bf16_t, WS_UMLP)};
            pg8::gemm_phase<EpiMlpIn, pg8::StaticOrder, true, true>(F.lds, g, S, E, F.wave);
        }
        SEAM(pb + 6);
        if (IN(pb + 7)) {
            pg8::Gemm g{WSP(bf16_t, WS_UMLP), (const bf16_t*)(wl + W_2), L, DM, DFF}; pg8::StaticOrder S; S.init(L, DM, F.G, (int)blockIdx.x);
            EpiResid E{(const float*)A.out, A.out, WSP(bf16_t, WS_XB), ssqp + (size_t)(2 * l + 2) * L * 32};
            pg8::gemm_phase<EpiResid, pg8::StaticOrder, true, true>(F.lds, g, S, E, F.wave);
            if (l + 1 < NLAYER) { VM_WAIT(); __syncthreads(); conv_layer(F, A, l + 1); }
        }
        SEAM(pb + 7);
    }
#undef IN
#undef SEAM
}


extern "C" void kernel_launch(void* const* d_in, const int* in_sizes, int n_in, void* d_out, int out_size, void* d_ws, size_t ws_size, hipStream_t stream) {
    static int grid = 0;
    if (grid == 0) {
        if (n_in != 16 || in_sizes[0] != L * DM || out_size != L * DM || ws_size < WS_END) {
            fprintf(stderr, "kernel_launch: shape mismatch: n_in %d in0 %d out %d ws %zu (need >= %zu); nothing launched\n", n_in, n_in > 0 ? in_sizes[0] : -1, out_size, ws_size, (size_t)WS_END); grid = -1; return; }
        int dev = 0, cus = 0;
        if (hipGetDevice(&dev) != hipSuccess || hipDeviceGetAttribute(&cus, hipDeviceAttributeMultiprocessorCount, dev) != hipSuccess) { fprintf(stderr, "kernel_launch: device query failed\n"); grid = -1; return; }
        if (hipFuncSetAttribute((const void*)fwd, hipFuncAttributeMaxDynamicSharedMemorySize, LDS_BYTES) != hipSuccess) { fprintf(stderr, "kernel_launch: hipFuncSetAttribute failed\n"); grid = -1; return; }
        int per_cu = 0;
        if (hipOccupancyMaxActiveBlocksPerMultiprocessor(&per_cu, (const void*)fwd, NWAVES * 64, LDS_BYTES) != hipSuccess || per_cu < 1)
            fprintf(stderr, "kernel_launch: note: occupancy query reports %d workgroups per CU\n", per_cu);
        (void)hipGetLastError();
        grid = cus > 256 ? 256 : cus;
    }
    if (grid < 0) return;
    (void)hipMemsetAsync((char*)d_ws + WS_CTL, 0, CTL_ZERO_BYTES, stream);
    Args a{};
    for (int i = 0; i < 16; ++i) a.in[i] = (const float*)d_in[i];
    a.out = (float*)d_out; a.ws = (unsigned char*)d_ws;
    for (int j = 0; j < 64; ++j) { const float pw = (float)std::pow(10000.0, (double)((float)(2 * j) / 128.0f)); a.inv[j] = 1.0f / pw; }
    for (int l = 0; l < 4; ++l) { const double li = 0.8 - 0.6 * std::exp(-0.3 * (double)l); a.lam_init[l] = (float)li; a.om_lam_init[l] = (float)(1.0 - li); }
#if MK_ONE_LAUNCH
    a.ph_lo = 0; a.ph_hi = N_PHASES;
    hipLaunchKernelGGL(fwd, dim3(grid), dim3(NWAVES * 64), LDS_BYTES, stream, a);
#else
    for (int ph = 0; ph < N_PHASES; ++ph) { a.ph_lo = ph; a.ph_hi = ph + 1; hipLaunchKernelGGL(fwd, dim3(grid), dim3(NWAVES * 64), LDS_BYTES, stream, a); }
#endif
    const hipError_t le = hipPeekAtLastError();
    if (le != hipSuccess) fprintf(stderr, "kernel_launch: launch failed: %s\n", hipGetErrorName(le));
}
```

```cpp
#include <hip/hip_runtime.h>
#include <cstdio>
#include <cstdint>
#include <cmath>

#ifndef MK_ONE_LAUNCH
#define MK_ONE_LAUNCH 1
#endif

constexpr int L = 8192, DM = 2048, NLAYER = 4, INC = 16384, DFF = 8192, HD = 128, NH = 8, DV2 = 256, CH = 128, NCH = L / CH;
constexpr float NORM_EPS = 1e-6f, GN_EPS = 1e-5f;
constexpr int NWAVES = 8;
namespace pg8 {
#define PG8_LAS __attribute__((address_space(3)))
typedef unsigned short bf16_t;
typedef short bf16x8 __attribute__((ext_vector_type(8)));
typedef float f32x4 __attribute__((ext_vector_type(4)));
typedef unsigned u32x4 __attribute__((ext_vector_type(4)));
constexpr int BM = 256, BK = 64, HALF = 128, HTB = HALF * BK * 2  , STAGE_BYTES = 8 * HTB, NXCD = 8, WGM = 4;

__host__ __device__ __forceinline__ int lds_byte(int r, int c) { const int st = (r >> 4) * 2 + (c >> 5), rr = r & 15, cc = c & 31, ob = rr * 64 + cc * 2; return st * 1024 + (ob ^ (((ob >> 9) & 1) << 5)); }
__host__ __device__ __forceinline__ void stage_rc(int b, int& R, int& C) { const int st = b / 1024, sb = b % 1024, swz = sb ^ (((sb >> 9) & 1) << 5); R = (st >> 1) * 16 + swz / 64; C = (st & 1) * 32 + (swz % 64) / 2; }
__host__ __device__ __forceinline__ int perm32(int rho) { const int n = rho >> 4, i = rho & 15; return 8 * (i >> 2) + 4 * n + (i & 3); }

struct Unit { int pm, pn; };
struct Gemm { const bf16_t* A; const bf16_t* Bt; int M, N, K; };

struct StaticOrder {
    int nM, nN, nwg, G, c;
    __host__ __device__ void init(int M, int N, int G_, int c_) { nM = M / BM; nN = N / BM; nwg = nM * nN; G = G_; c = c_; }
    __host__ __device__ bool next(int i, Unit& u) const {
        const long L = (long)i * G + c; if (L >= nwg) return false;
        int wgid = (int)L; { const int q = nwg / NXCD, r = nwg % NXCD, xcd = wgid % NXCD, off = wgid / NXCD; wgid = (xcd < r ? xcd * (q + 1) : r * (q + 1) + (xcd - r) * q) + off; }
        const int nig = WGM * nN, gid = wgid / nig, fm = gid * WGM, gsz = (nM - fm) < WGM ? (nM - fm) : WGM;
        u.pm = fm + ((wgid % nig) % gsz); u.pn = (wgid % nig) / gsz; return true;
    }
    __device__ __forceinline__ void a_ready(const Unit&) const {}
    __device__ __forceinline__ void done(const Unit&) const {}
};
template <class Epi, class Sched, bool ALIGN_EPI = false, bool SP2 = false>
__device__ __forceinline__ void gemm_phase(PG8_LAS unsigned char* lds, const Gemm g, const Sched& S, const Epi& E, const int wid_in  ) {
    int lane_; asm volatile("v_mbcnt_lo_u32_b32 %0, -1, 0\n\tv_mbcnt_hi_u32_b32 %0, -1, %0" : "=v"(lane_)); int wid_ = wid_in; asm volatile("" : "+s"(wid_)); const int wid = wid_ & 7, tid = wid * 64 + (lane_ & 63), lane = tid & 63, wr = wid >> 2, wc = wid & 3, fr = lane & 15, fq = lane >> 4;
    const int K = g.K, nt = K / BK;
    unsigned voffA[2], voffB[2];
#pragma unroll
    for (int i = 0; i < 2; ++i) { int R, C; stage_rc(tid * 16 + i * 8192, R, C); const int Rb = Epi::PERM ? ((R & ~31) + perm32(R & 31)) : R;
        voffA[i] = (unsigned)(R * K + C) * 2u; voffB[i] = (unsigned)(Rb * K + C) * 2u; }
    const size_t kstep = (size_t)(BK * 2);
    const size_t hstep = (size_t)HALF * K * 2;
    const size_t tstep = 2 * hstep;
    const unsigned ldsw = (unsigned)wid * 1024u;
    const int aoff = lds_byte(wr * 64 + fr, fq * 8), boff = lds_byte(wc * 32 + fr, fq * 8);
#define PG8_SA(b, h) (((b) * 2 + (h)) * HTB)
#define PG8_SB(b, h) ((4 + (b) * 2 + (h)) * HTB)
#define PG8_STAGE(bufoff, gbase, voff) do { _Pragma("unroll") for (int _i = 0; _i < 2; ++_i) \
        __builtin_amdgcn_global_load_lds((const unsigned*)((const char*)(gbase) + (voff)[_i]), (PG8_LAS unsigned*)(lds + (bufoff) + ldsw + _i * 8192), 16, 0, 0); } while (0)
#define PG8_LDA(dst, b, h) do { _Pragma("unroll") for (int m = 0; m < 4; ++m) _Pragma("unroll") for (int k = 0; k < 2; ++k) dst[m][k] = *(const PG8_LAS bf16x8*)(lds + PG8_SA(b, h) + aoff + m * 2048 + k * 1024); } while (0)
#define PG8_LDB(dst, b, h) do { _Pragma("unroll") for (int n = 0; n < 2; ++n) _Pragma("unroll") for (int k = 0; k < 2; ++k) dst[n][k] = *(const PG8_LAS bf16x8*)(lds + PG8_SB(b, h) + boff + n * 2048 + k * 1024); } while (0)
#define PG8_MMA(ai, bj, At, Bt) do { __builtin_amdgcn_s_setprio(1); _Pragma("unroll") for (int m = 0; m < 4; ++m) _Pragma("unroll") for (int n = 0; n < 2; ++n) _Pragma("unroll") for (int k = 0; k < 2; ++k) \
        acc[ai][bj][m][n] = __builtin_amdgcn_mfma_f32_16x16x32_bf16(Bt[n][k], At[m][k], acc[ai][bj][m][n], 0, 0, 0); __builtin_amdgcn_s_setprio(0); } while (0)
#define PG8_WAIT_V(n) asm volatile("s_waitcnt vmcnt(" #n ")" ::: "memory")
#define PG8_WAIT_L(n) asm volatile("s_waitcnt lgkmcnt(" #n ")" ::: "memory")
#define PG8_BAR __builtin_amdgcn_s_barrier()
#define PG8_SCHED __builtin_amdgcn_sched_barrier(0)
    Unit cur, nxt; int ui = 0;
    if (!S.next(0, cur)) return;
    f32x4 acc[2][2][4][2];
#pragma unroll
    for (int a = 0; a < 2; ++a)
#pragma unroll
        for (int b = 0; b < 2; ++b)
#pragma unroll
            for (int m = 0; m < 4; ++m)
#pragma unroll
                for (int n = 0; n < 2; ++n) acc[a][b][m][n] = (f32x4){0.f, 0.f, 0.f, 0.f};
    bf16x8 At[4][2], B0[2][2], B1[2][2];
    const char* cA = (const char*)g.A + (size_t)cur.pm * tstep; const char* cB = (const char*)g.Bt + (size_t)cur.pn * tstep;
    S.a_ready(cur);
    if constexpr (SP2) {
        PG8_STAGE(PG8_SB(0, 0), cB, voffB); PG8_STAGE(PG8_SB(0, 1), cB + hstep, voffB); PG8_STAGE(PG8_SA(0, 0), cA, voffA); PG8_STAGE(PG8_SA(0, 1), cA + hstep, voffA);
        if (wr == 1) PG8_BAR;
        PG8_WAIT_V(2); PG8_BAR;
        PG8_STAGE(PG8_SB(1, 0), cB + kstep, voffB); PG8_STAGE(PG8_SA(1, 0), cA + kstep, voffA); PG8_STAGE(PG8_SB(1, 1), cB + hstep + kstep, voffB);
        PG8_WAIT_V(6); PG8_BAR;
    } else {
        PG8_STAGE(PG8_SB(0, 0), cB, voffB); PG8_STAGE(PG8_SA(0, 0), cA, voffA); PG8_STAGE(PG8_SB(0, 1), cB + hstep, voffB); PG8_STAGE(PG8_SA(0, 1), cA + hstep, voffA);
        if (wr == 1) PG8_BAR;
        PG8_WAIT_V(4); PG8_BAR;
        PG8_STAGE(PG8_SB(1, 0), cB + kstep, voffB); PG8_STAGE(PG8_SA(1, 0), cA + kstep, voffA); PG8_STAGE(PG8_SB(1, 1), cB + hstep + kstep, voffB);
        PG8_WAIT_V(6); PG8_BAR;
    }
    for (;;) {
        const bool has_next = S.next(ui + 1, nxt);
        const char* nA = has_next ? (const char*)g.A + (size_t)nxt.pm * tstep : cA; const char* nB = has_next ? (const char*)g.Bt + (size_t)nxt.pn * tstep : cB;
        for (int t = 0; t < nt; t += 2) {
            const bool last = (t == nt - 2);
            const char* a1 = cA + (size_t)(t + 1) * kstep;
            const char* a2 = last ? nA : cA + (size_t)(t + 2) * kstep; const char* b2 = last ? nB : cB + (size_t)(t + 2) * kstep;
            const char* a3 = a2 + kstep; const char* b3 = b2 + kstep;
            if (last && has_next) S.a_ready(nxt);
            if constexpr (SP2) {
            PG8_LDB(B0, 0, 0); PG8_LDB(B1, 0, 1); PG8_SCHED; PG8_LDA(At, 0, 0); PG8_STAGE(PG8_SA(1, 1), a1 + hstep, voffA);
            PG8_WAIT_V(8); PG8_WAIT_L(0); PG8_BAR; PG8_MMA(0, 0, At, B0); PG8_MMA(0, 1, At, B1); PG8_BAR; PG8_SCHED;
            PG8_LDA(At, 0, 1); PG8_STAGE(PG8_SB(0, 0), b2, voffB); PG8_STAGE(PG8_SB(0, 1), b2 + hstep, voffB); PG8_STAGE(PG8_SA(0, 0), a2, voffA);
            PG8_WAIT_V(8); PG8_WAIT_L(0); PG8_BAR; PG8_MMA(1, 0, At, B0); PG8_MMA(1, 1, At, B1); PG8_BAR; PG8_SCHED;
            PG8_LDB(B0, 1, 0); PG8_LDB(B1, 1, 1); PG8_SCHED; PG8_LDA(At, 1, 0); PG8_STAGE(PG8_SA(0, 1), a2 + hstep, voffA);
            PG8_WAIT_V(8); PG8_WAIT_L(0); PG8_BAR; PG8_MMA(0, 0, At, B0); PG8_MMA(0, 1, At, B1); PG8_BAR; PG8_SCHED;
            PG8_LDA(At, 1, 1); PG8_STAGE(PG8_SB(1, 0), b3, voffB); PG8_STAGE(PG8_SB(1, 1), b3 + hstep, voffB); PG8_STAGE(PG8_SA(1, 0), a3, voffA);
            PG8_WAIT_V(8); PG8_WAIT_L(0); PG8_BAR; PG8_MMA(1, 0, At, B0); PG8_MMA(1, 1, At, B1); PG8_BAR; PG8_SCHED;
            } else {
            PG8_LDB(B0, 0, 0); PG8_SCHED; PG8_LDA(At, 0, 0); PG8_STAGE(PG8_SA(1, 1), a1 + hstep, voffA);
            PG8_WAIT_L(8); PG8_BAR; PG8_WAIT_L(0); PG8_MMA(0, 0, At, B0); PG8_BAR; PG8_SCHED;
            PG8_LDB(B1, 0, 1); PG8_STAGE(PG8_SB(0, 0), b2, voffB);
            PG8_BAR; PG8_WAIT_L(0); PG8_MMA(0, 1, At, B1); PG8_BAR;
            PG8_LDA(At, 0, 1); PG8_STAGE(PG8_SA(0, 0), a2, voffA);
            PG8_BAR; PG8_WAIT_L(0); PG8_MMA(1, 0, At, B0); PG8_BAR; PG8_SCHED;
            PG8_STAGE(PG8_SB(0, 1), b2 + hstep, voffB);
            PG8_WAIT_V(6); PG8_BAR; PG8_MMA(1, 1, At, B1); PG8_BAR;
            PG8_LDB(B0, 1, 0); PG8_SCHED; PG8_LDA(At, 1, 0); PG8_STAGE(PG8_SA(0, 1), a2 + hstep, voffA);
            PG8_WAIT_L(8); PG8_BAR; PG8_WAIT_L(0); PG8_MMA(0, 0, At, B0); PG8_BAR; PG8_SCHED;
            PG8_LDB(B1, 1, 1); PG8_STAGE(PG8_SB(1, 0), b3, voffB);
            PG8_BAR; PG8_WAIT_L(0); PG8_MMA(0, 1, At, B1); PG8_BAR;
            PG8_LDA(At, 1, 1); PG8_STAGE(PG8_SA(1, 0), a3, voffA);
            PG8_BAR; PG8_WAIT_L(0); PG8_MMA(1, 0, At, B0); PG8_BAR; PG8_SCHED;
            PG8_STAGE(PG8_SB(1, 1), b3 + hstep, voffB);
            PG8_WAIT_V(6); PG8_BAR; PG8_MMA(1, 1, At, B1); PG8_BAR;
            }
        }
        if constexpr (ALIGN_EPI) { if (wr == 0) PG8_BAR; }
        if constexpr (!Epi::AFTER_DRAIN) { E(acc, cur, wr, wc, fr, fq); S.done(cur); }
        if (!has_next) break;
#pragma unroll
        for (int a = 0; a < 2; ++a)
#pragma unroll
            for (int b = 0; b < 2; ++b)
#pragma unroll
                for (int m = 0; m < 4; ++m)
#pragma unroll
                    for (int n = 0; n < 2; ++n) acc[a][b][m][n] = (f32x4){0.f, 0.f, 0.f, 0.f};
        cur = nxt; cA = nA; cB = nB; ++ui;
        if constexpr (ALIGN_EPI) { if (wr == 1) PG8_BAR; }
    }
    PG8_WAIT_V(0);
    if constexpr (!ALIGN_EPI) { if (wr == 0) PG8_BAR; }
    PG8_BAR;
    if constexpr (Epi::AFTER_DRAIN) { E.fused(acc, cur, wr, wc, fr, fq, lds, wid, lane); S.done(cur); }
#undef PG8_SA
#undef PG8_SB
#undef PG8_STAGE
#undef PG8_LDA
#undef PG8_LDB
#undef PG8_MMA
#undef PG8_WAIT_V
#undef PG8_WAIT_L
#undef PG8_BAR
#undef PG8_SCHED
}
}

constexpr size_t MiB = 1u << 20;
constexpr size_t WS_CTL = 0, CTL_ZERO_BYTES = 1 * MiB;
constexpr size_t WS_CONST = 2 * MiB;
constexpr size_t WS_ROPE = 4 * MiB;
constexpr size_t WS_W = 16 * MiB, W_LAYER = 152 * MiB;
constexpr size_t W_IN = 0, W_RO = 64 * MiB, W_DO = 72 * MiB, W_OUT = 80 * MiB, W_1 = 88 * MiB, W_2 = 120 * MiB;
constexpr size_t WS_XB = 640 * MiB, WS_QR = 672 * MiB, WS_KR = 688 * MiB, WS_VR = 704 * MiB, WS_GR = 736 * MiB, WS_DQ = 768 * MiB, WS_DK = 800 * MiB,
                 WS_DV = 832 * MiB, WS_SGR = 864 * MiB, WS_SGD = 896 * MiB, WS_KVF = 928 * MiB, WS_KVB = 992 * MiB, WS_STF = 1056 * MiB, WS_STB = 1088 * MiB,
                 WS_URET = 1120 * MiB, WS_ODIFF = 1152 * MiB, WS_T1 = 1184 * MiB, WS_MERGED = 1248 * MiB, WS_UMLP = 1280 * MiB, WS_ATT = 1408 * MiB, WS_SSQP = 1472 * MiB, WS_END = 1488 * MiB;
constexpr int CW_TMO = 0, CW_BAR = 4096;

constexpr int LDS_BYTES = 155648;
constexpr int MISC_OFF = 153600;

#define GAS __attribute__((address_space(1)))
#define LAS __attribute__((address_space(3)))
typedef unsigned short bf16_t;
typedef unsigned v4u __attribute__((ext_vector_type(4)));
typedef unsigned v2u __attribute__((ext_vector_type(2)));
typedef float f32x4 __attribute__((ext_vector_type(4)));
typedef float f32x16 __attribute__((ext_vector_type(16)));
typedef short bf16x8 __attribute__((ext_vector_type(8)));
typedef short s16x4 __attribute__((ext_vector_type(4)));
typedef GAS unsigned gu32;
#define RLX_AGENT __ATOMIC_RELAXED, __HIP_MEMORY_SCOPE_AGENT
#define LDS_WAIT() asm volatile("s_waitcnt lgkmcnt(0)" ::: "memory")
#define VM_WAIT() asm volatile("s_waitcnt vmcnt(0)" ::: "memory")
#define SBAR() __builtin_amdgcn_sched_barrier(0)
__device__ __forceinline__ unsigned f2bf(float f) { unsigned u = __builtin_bit_cast(unsigned, f); return (u + 0x7fffu + ((u >> 16) & 1u)) >> 16; }
__device__ __forceinline__ unsigned pk2(float lo, float hi) { return f2bf(lo) | (f2bf(hi) << 16); }
__device__ __forceinline__ float bf2f(unsigned short b) { return __builtin_bit_cast(float, (unsigned)b << 16); }
__device__ __forceinline__ float bflo(unsigned w) { return __builtin_bit_cast(float, w << 16); }
__device__ __forceinline__ float bfhi(unsigned w) { return __builtin_bit_cast(float, w & 0xffff0000u); }
__device__ __forceinline__ unsigned cvtpk(float lo, float hi) { unsigned r; asm volatile("v_cvt_pk_bf16_f32 %0, %1, %2" : "=v"(r) : "v"(lo), "v"(hi)); return r; }
__device__ __forceinline__ int crow(int r, int hi) { return (r & 3) + 8 * (r >> 2) + 4 * hi; }
__device__ __forceinline__ int lane_id() { int l; asm volatile("v_mbcnt_lo_u32_b32 %0, -1, 0\n\tv_mbcnt_hi_u32_b32 %0, -1, %0" : "=v"(l)); return l; }
template <int M> __device__ __forceinline__ float sw_xor(float v) { return __builtin_bit_cast(float, __builtin_amdgcn_ds_swizzle(__builtin_bit_cast(int, v), (M << 10) | 0x1f)); }
__device__ __forceinline__ void swap32(float& a, float& b) { asm volatile("s_nop 1\n\tv_permlane32_swap_b32 %0, %1\n\ts_nop 1" : "+v"(a), "+v"(b)); }
__device__ __forceinline__ float add_xor32(float v) { float a = v, b = v; swap32(a, b); return a + b; }
__device__ __forceinline__ float max_xor32(float v) { float a = v, b = v; swap32(a, b); return fmaxf(a, b); }
__device__ __forceinline__ float sum16(float v) { v += sw_xor<1>(v); v += sw_xor<2>(v); v += sw_xor<4>(v); v += sw_xor<8>(v); return v; }
__device__ __forceinline__ float sum32(float v) { v = sum16(v); v += sw_xor<16>(v); return v; }
__device__ __forceinline__ int opaque(int x) { asm volatile("" : "+v"(x)); return x & 511; }
__device__ __forceinline__ float wave_sum(float v) { return add_xor32(sum32(v)); }
__device__ __forceinline__ float wave_max(float v) { v = fmaxf(v, sw_xor<1>(v)); v = fmaxf(v, sw_xor<2>(v)); v = fmaxf(v, sw_xor<4>(v)); v = fmaxf(v, sw_xor<8>(v)); v = fmaxf(v, sw_xor<16>(v)); return max_xor32(v); }
__device__ __forceinline__ float fsigmoid(float x) { return __builtin_amdgcn_rcpf(1.f + __expf(-x)); }
typedef __amdgpu_buffer_rsrc_t rsrc_t;
__device__ __forceinline__ rsrc_t mk_rsrc(const void* p, unsigned bytes) { return __builtin_amdgcn_make_buffer_rsrc((void*)p, (short)0, (int)bytes, 0x00020000); }
__device__ __forceinline__ void st16_wt(rsrc_t r, unsigned off, v4u v) { __builtin_amdgcn_raw_buffer_store_b128(v, r, (int)off, 0, 16); }

#define XB_TMO      128
#define XB_XCNT(j)  (256  + 64 * (j))
#define XB_XSUB(j)  (1280 + 64 * (j))
#define XB_XGEN(j)  (2304 + 64 * (j))
#define XB_TOP      3328
#define XB_TOPGEN   3392
#define XCD_BAR_WORDS 3456
#define XB_SPIN_CAP (1u << 18)
__device__ __forceinline__ unsigned xb_ld(unsigned* p)              { return __hip_atomic_load(p, __ATOMIC_RELAXED, __HIP_MEMORY_SCOPE_AGENT); }
__device__ __forceinline__ unsigned xb_add(unsigned* p, unsigned v) { return __hip_atomic_fetch_add(p, v, __ATOMIC_RELAXED, __HIP_MEMORY_SCOPE_AGENT); }
__device__ __forceinline__ unsigned xb_xcc_id() { return (unsigned)__builtin_amdgcn_s_getreg((3 << 11) | 20) & 0xFu; }
#define XB_SPIN(cond, bar) do { unsigned _sp = 0; while (cond) { __builtin_amdgcn_s_sleep(1); \
    if ((++_sp & 255u) == 0u) { if (xb_ld(&(bar)[XB_TMO])) break; if (_sp > XB_SPIN_CAP) { atomicAdd(&(bar)[XB_TMO], 1u); break; } } } } while (0)
struct XcdBarrier { unsigned* bar; unsigned x; volatile LAS unsigned* st; };
__device__ __forceinline__ XcdBarrier xcd_barrier_post(unsigned* bar, volatile LAS unsigned* st, bool leader) {
    XcdBarrier b; b.bar = bar; b.x = xb_xcc_id(); b.st = st;
    if (leader) (void)xb_add(&bar[XB_XCNT(b.x)], 1u);
    return b;
}
__device__ __forceinline__ void xcd_barrier_complete(unsigned* bar, unsigned x, unsigned& nloc, unsigned& nx) {
    const unsigned G = gridDim.x * gridDim.y * gridDim.z;
    unsigned sum, cnt, mine, sp = 0u;
    for (;;) {
        sum = 0u; cnt = 0u; mine = 0u;
#pragma unroll
        for (unsigned j = 0; j < 16; ++j) { const unsigned c = xb_ld(&bar[XB_XCNT(j)]); sum += c; cnt += (c > 0u) ? 1u : 0u; mine = (j == x) ? c : mine; }
        if (sum == G) break;
        __builtin_amdgcn_s_sleep(1);
        if ((++sp & 255u) == 0u) { if (xb_ld(&bar[XB_TMO])) break; if (sp > XB_SPIN_CAP) { atomicAdd(&bar[XB_TMO], 1u); break; } }
    }
    nloc = mine > 0u ? mine : 1u; nx = cnt > 0u ? cnt : 1u;
}
__device__ __forceinline__ void xcd_barrier(const XcdBarrier& b, bool leader  ) {
    asm volatile("s_waitcnt vmcnt(0)" ::: "memory");
    __syncthreads();
    if (leader) {
        unsigned* bar = b.bar;
        __builtin_amdgcn_s_waitcnt(0);
        unsigned nloc = b.st[0], nx = b.st[1];
        if (nloc == 0u) { xcd_barrier_complete(bar, b.x, nloc, nx); b.st[0] = nloc; b.st[1] = nx; }
        const unsigned old = xb_add(&bar[XB_XSUB(b.x)], 1u);
        const unsigned gen = old / nloc;
        if (old + 1u == (gen + 1u) * nloc) {
            __builtin_amdgcn_fence(__ATOMIC_RELEASE, "agent");
            asm volatile("s_waitcnt vmcnt(0)" ::: "memory");
            const unsigned og = xb_add(&bar[XB_TOP], 1u);
            const unsigned tg = og / nx;
            if (og + 1u == (tg + 1u) * nx) xb_add(&bar[XB_TOPGEN], 1u);
            else XB_SPIN(xb_ld(&bar[XB_TOPGEN]) == tg, bar);
            __builtin_amdgcn_fence(__ATOMIC_ACQUIRE, "agent");
            xb_add(&bar[XB_XGEN(b.x)], 1u);
            asm volatile("s_waitcnt vmcnt(0)" ::: "memory");
        } else {
            XB_SPIN(xb_ld(&bar[XB_XGEN(b.x)]) == gen, bar);
            __builtin_amdgcn_fence(__ATOMIC_ACQUIRE, "agent");
            asm volatile("s_waitcnt vmcnt(0)" ::: "memory");
        }
    }
    __syncthreads();
}

struct Args {
    const float* in[16]; float* out; unsigned char* ws;
    float inv[64];
    float om_lam_init[4];
    float lam_init[4];
    int ph_lo, ph_hi, pad0, pad1;
};
struct Frame {
    LAS unsigned char* lds;
    unsigned char* ws;
    int tid, lane, wave, G;
};
#define WSP(T, off) ((T*)(F.ws + (off)))

using pg8::Unit;
__device__ __forceinline__ void rows_rs(const float* ssqp, int row0, int fq, float (&rs)[2][4]) {
    f32x4 pa[2][4], pb[2][4];
#pragma unroll
    for (int ai = 0; ai < 2; ++ai)
#pragma unroll
        for (int m = 0; m < 4; ++m) { const f32x4* p = (const f32x4*)(ssqp + (size_t)(row0 + ai * 128 + m * 16) * 32) + 2 * fq; pa[ai][m] = p[0]; pb[ai][m] = p[1]; }
#pragma unroll
    for (int ai = 0; ai < 2; ++ai)
#pragma unroll
        for (int m = 0; m < 4; ++m) { const f32x4 q = pa[ai][m] + pb[ai][m]; float t = (q[0] + q[1]) + (q[2] + q[3]); t += sw_xor<16>(t); t = add_xor32(t);
            rs[ai][m] = __builtin_amdgcn_rsqf(t * (1.0f / DM) + NORM_EPS); }
}
constexpr int RS_OFF = 139264;
__device__ __forceinline__ void rs_panel_to_lds(LAS unsigned char* lds, const float* ssqp, int pm, int tid) {
    if (tid < 256) { const f32x4* p = (const f32x4*)(ssqp + (size_t)(pm * 256 + tid) * 32); f32x4 q = p[0];
#pragma unroll
        for (int i = 1; i < 8; ++i) q += p[i];
        ((LAS float*)(lds + RS_OFF))[tid] = __builtin_amdgcn_rsqf(((q[0] + q[1]) + (q[2] + q[3])) * (1.0f / DM) + NORM_EPS); }
    __syncthreads();
}
__device__ __forceinline__ void rows_rs_c(LAS float* rsl, int prow, float (&rs)[2][4]) {
#pragma unroll
    for (int ai = 0; ai < 2; ++ai)
#pragma unroll
        for (int m = 0; m < 4; ++m) rs[ai][m] = rsl[prow + ai * 128 + m * 16];
}
struct EpiInProj {
    static constexpr bool PERM = true, AFTER_DRAIN = false;
    const float* ssqp; const float* cs; unsigned char* ws; LAS float* xch; const float* qw; const float* kw; LAS float* rsl; int pm_c;
    __device__ __forceinline__ void operator()(const f32x4 (&acc)[2][2][4][2], const Unit& u, int wr, int wc, int fr_, int fq_) const {
        (void)fr_; (void)fq_; const int ln_ = lane_id() & 63, fr = ln_ & 15, fq = ln_ >> 4;
        const int pn = u.pn, seg = pn >> 2, id = seg < 2 ? seg : (seg >> 1) + 1;
        const size_t boff = WS_QR + (size_t)(id < 2 ? 16 * id : 32 * (id - 1)) * MiB;
        const int ld = id < 2 ? 1024 : 2048, cb = (pn - (id < 2 ? 4 * id : 8 * (id - 1))) * 256;
        const int op = id < 2 ? 1 : (id == 3 ? 2 : (id >= 7 ? 3 : ((id == 4 || id == 5) ? 4 : 0)));
        const float sc = id == 1 ? 0.08838834764831845f : 1.0f;
        bf16_t* base = (bf16_t*)(ws + boff);
        const int row0 = u.pm * 256 + wr * 64 + fr, col0 = cb + wc * 32 + 8 * fq, j0 = 16 * wc + 4 * fq;
        float rs[2][4]; rows_rs_c(rsl, wr * 64 + fr, rs);
        if (op == 1) {
#pragma unroll
            for (int ai = 0; ai < 2; ++ai) {
                f32x4 ca[4], cb4[4];
#pragma unroll
                for (int m = 0; m < 4; ++m) { const GAS f32x4* cp = (const GAS f32x4*)(cs + ((size_t)(row0 + ai * 128 + m * 16) * 64 + j0) * 2); ca[m] = cp[0]; cb4[m] = cp[1]; }
#pragma unroll
                for (int m = 0; m < 4; ++m) {
                    bf16_t* rowp = base + (size_t)(row0 + ai * 128 + m * 16) * ld + col0; const f32x4 c0 = ca[m], c1 = cb4[m]; const float r = rs[ai][m] * sc;
#pragma unroll
                    for (int bj = 0; bj < 2; ++bj) {
                        const f32x4 v0 = acc[ai][bj][m][0] * r, v1 = acc[ai][bj][m][1] * r;
                        v4u w; w.x = cvtpk(v0[0] * c0[0] - v0[1] * c0[1], v0[1] * c0[0] + v0[0] * c0[1]); w.y = cvtpk(v0[2] * c0[2] - v0[3] * c0[3], v0[3] * c0[2] + v0[2] * c0[3]);
                        w.z = cvtpk(v1[0] * c1[0] - v1[1] * c1[1], v1[1] * c1[0] + v1[0] * c1[1]); w.w = cvtpk(v1[2] * c1[2] - v1[3] * c1[3], v1[3] * c1[2] + v1[2] * c1[3]);
                        *(GAS v4u*)(rowp + bj * 128) = w;
                    }
                }
                asm volatile("" ::: "memory");
            }
        } else if (op == 4) {
            LAS float* xp = xch + wr * 1024;
#pragma unroll
            for (int ai = 0; ai < 2; ++ai)
#pragma unroll
                for (int m = 0; m < 4; ++m)
#pragma unroll
                    for (int bj = 0; bj < 2; ++bj) { const f32x4 v0 = acc[ai][bj][m][0], v1 = acc[ai][bj][m][1];
                        float ss = (v0[0] * v0[0] + v0[1] * v0[1]) + (v0[2] * v0[2] + v0[3] * v0[3]) + (v1[0] * v1[0] + v1[1] * v1[1]) + (v1[2] * v1[2] + v1[3] * v1[3]);
                        ss += sw_xor<16>(ss); ss = add_xor32(ss);
                        if (fq == 0) xp[((ai * 4 + m) * 16 + fr) * 8 + bj * 4 + wc] = ss; }
            asm volatile("s_waitcnt lgkmcnt(0)" ::: "memory"); __builtin_amdgcn_s_barrier(); asm volatile("" ::: "memory");
            const float* gw = (id == 4) ? qw : kw;
            const f32x4 w1 = *(const GAS f32x4*)(gw + j0), w2 = *(const GAS f32x4*)(gw + 64 + j0);
#pragma unroll
            for (int ai = 0; ai < 2; ++ai) {
                f32x4 ca[4], cb4[4];
#pragma unroll
                for (int m = 0; m < 4; ++m) { const GAS f32x4* cp = (const GAS f32x4*)(cs + ((size_t)(row0 + ai * 128 + m * 16) * 64 + j0) * 2); ca[m] = cp[0]; cb4[m] = cp[1]; }
#pragma unroll
                for (int m = 0; m < 4; ++m) {
                    bf16_t* rowp = base + (size_t)(row0 + ai * 128 + m * 16) * ld + col0; const f32x4 c0 = ca[m], c1 = cb4[m]; const float r = rs[ai][m];
#pragma unroll
                    for (int bj = 0; bj < 2; ++bj) {
                        const f32x4 t = *(const LAS f32x4*)(xp + ((ai * 4 + m) * 16 + fr) * 8 + bj * 4);
                        const float cn = r * __builtin_amdgcn_rsqf(((t[0] + t[1]) + (t[2] + t[3])) * (r * r) * (1.0f / HD) + NORM_EPS);
                        const f32x4 v0 = acc[ai][bj][m][0] * cn, v1 = acc[ai][bj][m][1] * cn;
                        const float a0 = v0[0] * w1[0], b0 = v0[1] * w2[0], a1 = v0[2] * w1[1], b1 = v0[3] * w2[1], a2 = v1[0] * w1[2], b2 = v1[1] * w2[2], a3 = v1[2] * w1[3], b3 = v1[3] * w2[3];
                        v4u w; w.x = cvtpk(a0 * c0[0] - b0 * c0[1], b0 * c0[0] + a0 * c0[1]); w.y = cvtpk(a1 * c0[2] - b1 * c0[3], b1 * c0[2] + a1 * c0[3]);
                        w.z = cvtpk(a2 * c1[0] - b2 * c1[1], b2 * c1[0] + a2 * c1[1]); w.w = cvtpk(a3 * c1[2] - b3 * c1[3], b3 * c1[2] + a3 * c1[3]);
                        *(GAS v4u*)(rowp + bj * 128) = w;
                    }
                }
                asm volatile("" ::: "memory");
            }
        } else {
#pragma unroll
            for (int ai = 0; ai < 2; ++ai)
#pragma unroll
                for (int m = 0; m < 4; ++m) {
                    bf16_t* rowp = base + (size_t)(row0 + ai * 128 + m * 16) * ld + col0; const float r = rs[ai][m];
#pragma unroll
                    for (int bj = 0; bj < 2; ++bj) {
                        f32x4 v0 = acc[ai][bj][m][0] * r, v1 = acc[ai][bj][m][1] * r;
                        if (op == 2) {
#pragma unroll
                            for (int e = 0; e < 4; ++e) { v0[e] = v0[e] * fsigmoid(v0[e]); v1[e] = v1[e] * fsigmoid(v1[e]); }
                        } else if (op == 3) {
#pragma unroll
                            for (int e = 0; e < 4; ++e) { v0[e] = fsigmoid(v0[e]); v1[e] = fsigmoid(v1[e]); }
                        }
                        v4u w; w.x = cvtpk(v0[0], v0[1]); w.y = cvtpk(v0[2], v0[3]); w.z = cvtpk(v1[0], v1[1]); w.w = cvtpk(v1[2], v1[3]);
                        *(GAS v4u*)(rowp + bj * 128) = w;
                    }
                }
        }
    }
};
struct EpiGateA {
    static constexpr bool PERM = true, AFTER_DRAIN = false;
    const bf16_t* sg; bf16_t* T1;
    __device__ __forceinline__ void operator()(const f32x4 (&acc)[2][2][4][2], const Unit& u, int wr, int wc, int fr_, int fq_) const {
        (void)fr_; (void)fq_; const int ln_ = lane_id() & 63, fr = ln_ & 15, fq = ln_ >> 4;
        const int row0 = u.pm * 256 + wr * 64 + fr, col0 = u.pn * 256 + wc * 32 + 8 * fq;
        v4u g[2][4][2];
#pragma unroll
        for (int ai = 0; ai < 2; ++ai)
#pragma unroll
            for (int m = 0; m < 4; ++m)
#pragma unroll
                for (int bj = 0; bj < 2; ++bj) g[ai][m][bj] = *(const GAS v4u*)(sg + (size_t)(row0 + ai * 128 + m * 16) * DM + col0 + bj * 128);
#pragma unroll
        for (int ai = 0; ai < 2; ++ai)
#pragma unroll
            for (int m = 0; m < 4; ++m)
#pragma unroll
                for (int bj = 0; bj < 2; ++bj) {
                    const size_t off = (size_t)(row0 + ai * 128 + m * 16) * DM + col0 + bj * 128; const v4u q = g[ai][m][bj];
                    f32x4 v0 = acc[ai][bj][m][0], v1 = acc[ai][bj][m][1];
                    v0[0] *= bflo(q.x); v0[1] *= bfhi(q.x); v0[2] *= bflo(q.y); v0[3] *= bfhi(q.y);
                    v1[0] *= bflo(q.z); v1[1] *= bfhi(q.z); v1[2] *= bflo(q.w); v1[3] *= bfhi(q.w);
                    { v4u w; w.x = cvtpk(v0[0], v0[1]); w.y = cvtpk(v0[2], v0[3]); w.z = cvtpk(v1[0], v1[1]); w.w = cvtpk(v1[2], v1[3]); *(GAS v4u*)(T1 + off) = w; }
                }
    }
};
struct EpiGateB {
    static constexpr bool PERM = true, AFTER_DRAIN = false;
    const bf16_t* sg; const bf16_t* T1; bf16_t* out;
    __device__ __forceinline__ void operator()(const f32x4 (&acc)[2][2][4][2], const Unit& u, int wr, int wc, int fr_, int fq_) const {
        (void)fr_; (void)fq_; const int ln_ = lane_id() & 63, fr = ln_ & 15, fq = ln_ >> 4;
        const int row0 = u.pm * 256 + wr * 64 + fr, col0 = u.pn * 256 + wc * 32 + 8 * fq; const rsrc_t oo = mk_rsrc(out, (unsigned)L * DM * 2u);
#pragma unroll
        for (int ai = 0; ai < 2; ++ai) {
            v4u g[4][2], tq[4][2];
#pragma unroll
            for (int m = 0; m < 4; ++m)
#pragma unroll
                for (int bj = 0; bj < 2; ++bj) { const size_t off = (size_t)(row0 + ai * 128 + m * 16) * DM + col0 + bj * 128;
                    g[m][bj] = *(const GAS v4u*)(sg + off); tq[m][bj] = *(const GAS v4u*)(T1 + off); }
#pragma unroll
            for (int m = 0; m < 4; ++m)
#pragma unroll
                for (int bj = 0; bj < 2; ++bj) { const size_t off = (size_t)(row0 + ai * 128 + m * 16) * DM + col0 + bj * 128; const v4u q = g[m][bj], tt = tq[m][bj]; const f32x4 a0 = {bflo(tt.x), bfhi(tt.x), bflo(tt.y), bfhi(tt.y)}, a1 = {bflo(tt.z), bfhi(tt.z), bflo(tt.w), bfhi(tt.w)};
                    f32x4 v0 = acc[ai][bj][m][0], v1 = acc[ai][bj][m][1];
                    v0[0] = a0[0] + v0[0] * bflo(q.x); v0[1] = a0[1] + v0[1] * bfhi(q.x); v0[2] = a0[2] + v0[2] * bflo(q.y); v0[3] = a0[3] + v0[3] * bfhi(q.y);
                    v1[0] = a1[0] + v1[0] * bflo(q.z); v1[1] = a1[1] + v1[1] * bfhi(q.z); v1[2] = a1[2] + v1[2] * bflo(q.w); v1[3] = a1[3] + v1[3] * bfhi(q.w);
                    v4u w; w.x = cvtpk(v0[0], v0[1]); w.y = cvtpk(v0[2], v0[3]); w.z = cvtpk(v1[0], v1[1]); w.w = cvtpk(v1[2], v1[3]);
                    st16_wt(oo, (unsigned)off * 2u, w); }
            asm volatile("" ::: "memory");
        }
    }
};
struct EpiResid {
    static constexpr bool PERM = true, AFTER_DRAIN = false;
    float* xout; bf16_t* xb; float* ssqp_out;
    __device__ __forceinline__ void operator()(const f32x4 (&acc)[2][2][4][2], const Unit& u, int wr, int wc, int fr_, int fq_) const {
        (void)fr_; (void)fq_; const int ln_ = lane_id() & 63, fr = ln_ & 15, fq = ln_ >> 4;
        const int row0 = u.pm * 256 + wr * 64 + fr, col0 = u.pn * 256 + wc * 32 + 8 * fq; const rsrc_t oxb = mk_rsrc(xb, (unsigned)L * DM * 2u);
#pragma unroll
        for (int ai = 0; ai < 2; ++ai) {
            v4u xq[4][2];
#pragma unroll
            for (int m = 0; m < 4; ++m)
#pragma unroll
                for (int bj = 0; bj < 2; ++bj) { const size_t off = (size_t)(row0 + ai * 128 + m * 16) * DM + col0 + bj * 128; xq[m][bj] = *(const GAS v4u*)(xb + off); }
#pragma unroll
            for (int m = 0; m < 4; ++m) {
                const int row = row0 + ai * 128 + m * 16; float ps = 0.f;
#pragma unroll
                for (int bj = 0; bj < 2; ++bj) {
                    const size_t off = (size_t)row * DM + col0 + bj * 128; const v4u q = xq[m][bj];
                    f32x4 v0 = acc[ai][bj][m][0], v1 = acc[ai][bj][m][1];
                    v0[0] += bflo(q.x); v0[1] += bfhi(q.x); v0[2] += bflo(q.y); v0[3] += bfhi(q.y); v1[0] += bflo(q.z); v1[1] += bfhi(q.z); v1[2] += bflo(q.w); v1[3] += bfhi(q.w);
                    if (xout) { *(GAS f32x4*)(xout + off) = v0; *(GAS f32x4*)(xout + off + 4) = v1; }
                    ps += (v0[0] * v0[0] + v0[1] * v0[1]) + (v0[2] * v0[2] + v0[3] * v0[3]) + (v1[0] * v1[0] + v1[1] * v1[1]) + (v1[2] * v1[2] + v1[3] * v1[3]);
                    v4u w; w.x = cvtpk(v0[0], v0[1]); w.y = cvtpk(v0[2], v0[3]); w.z = cvtpk(v1[0], v1[1]); w.w = cvtpk(v1[2], v1[3]);
                    st16_wt(oxb, (unsigned)off * 2u, w);
                }
                ps += sw_xor<16>(ps); ps = add_xor32(ps);
                if (fq == 0) ((GAS float*)ssqp_out)[(size_t)row * 32 + u.pn * 4 + wc] = ps;
            }
            asm volatile("" ::: "memory");
        }
    }
};
struct EpiMlpIn {
    static constexpr bool PERM = true, AFTER_DRAIN = false;
    const float* ssqp; bf16_t* out; LAS float* rsl; int pm_c;
    __device__ __forceinline__ void operator()(const f32x4 (&acc)[2][2][4][2], const Unit& u, int wr, int wc, int fr_, int fq_) const {
        (void)fr_; (void)fq_; const int ln_ = lane_id() & 63, fr = ln_ & 15, fq = ln_ >> 4;
        const int row0 = u.pm * 256 + wr * 64 + fr, col0 = u.pn * 256 + wc * 32 + 8 * fq;
        float rs[2][4]; rows_rs_c(rsl, wr * 64 + fr, rs);
#pragma unroll
        for (int ai = 0; ai < 2; ++ai)
#pragma unroll
            for (int m = 0; m < 4; ++m) {
                const int row = row0 + ai * 128 + m * 16; const float r = rs[ai][m];
#pragma unroll
                for (int bj = 0; bj < 2; ++bj) {
                    f32x4 v0 = acc[ai][bj][m][0] * r, v1 = acc[ai][bj][m][1] * r;
#pragma unroll
                    for (int e = 0; e < 4; ++e) { const float a = fmaxf(v0[e], 0.f), b = fmaxf(v1[e], 0.f); v0[e] = a * a; v1[e] = b * b; }
                    v4u w; w.x = cvtpk(v0[0], v0[1]); w.y = cvtpk(v0[2], v0[3]); w.z = cvtpk(v1[0], v1[1]); w.w = cvtpk(v1[2], v1[3]);
                    *(GAS v4u*)(out + (size_t)row * DFF + col0 + bj * 128) = w;
                }
            }
    }
};

__device__ __forceinline__ float log2_gamma_calc(const float* logit) { const float x = *logit; return -log1pf(expf(-x)) * 1.4426950408889634f; }
__device__ __forceinline__ int srccol_win(int n) {
    const bool p = (n < 2048) || (n >= 6144 && n < 10240);
    return p ? ((n & ~127) + ((n & 127) >> 1) + ((n & 1) << 6)) : n;
}
constexpr int CP = 68;
struct ConvItem { const float* W; bf16_t* WT; const float* rscale; int K, N, rmask, k0, n0; float mulc; bool perm; };
__device__ __forceinline__ void conv_load(const ConvItem& d, f32x4 (&v)[16], int lane) {
    const int s4 = (lane & 15) * 4;
    const int col = d.perm ? ((d.n0 & ~127) + ((d.n0 & 127) >> 1) + (s4 & 31) + ((s4 >> 5) << 6)) : d.n0 + s4;
#pragma unroll
    for (int i = 0; i < 16; ++i) { const int kk = 4 * i + (lane >> 4); v[i] = __builtin_nontemporal_load((const f32x4*)(d.W + (size_t)(d.k0 + kk) * d.N + col)); }
}
__device__ __forceinline__ void conv_store(const ConvItem& d, const f32x4 (&v)[16], LAS float* scr, int lane) {
    const int s4 = (lane & 15) * 4;
#pragma unroll
    for (int i = 0; i < 16; ++i) { const int kk = 4 * i + (lane >> 4); const float sc = d.rscale ? d.rscale[(d.k0 + kk) & d.rmask] * d.mulc : 1.0f;
        *(LAS f32x4*)(scr + kk * CP + s4) = v[i] * sc; }
    LDS_WAIT(); asm volatile("" ::: "memory");
    const int c = lane & 7;
#pragma unroll
    for (int j = 0; j < 8; ++j) { const int r = (lane >> 3) + 8 * j, sidx = d.perm ? ((r >> 1) + 32 * (r & 1)) : r; const LAS float* q = scr + (8 * c) * CP + sidx;
        v4u o; o.x = pk2(q[0 * CP], q[1 * CP]); o.y = pk2(q[2 * CP], q[3 * CP]); o.z = pk2(q[4 * CP], q[5 * CP]); o.w = pk2(q[6 * CP], q[7 * CP]);
        *(v4u*)(d.WT + (size_t)(d.n0 + r) * d.K + d.k0 + 8 * c) = o; }
    LDS_WAIT(); asm volatile("" ::: "memory");
}
__device__ __forceinline__ void sincos_f32angle(float angf, float& c, float& s) {
    const double a = (double)angf;
    const double kq = __builtin_rint(a * 0.63661977236758134308);
    const double r = (a - kq * 1.5707963267948966192) - kq * 6.123233995736766e-17;
    const double r2 = r * r;
    double sp = -7.647163731819816e-13; sp = sp * r2 + 1.6059043836821613e-10; sp = sp * r2 - 2.5052108385441720e-08; sp = sp * r2 + 2.7557319223985893e-06;
    sp = sp * r2 - 1.9841269841269841e-04; sp = sp * r2 + 8.3333333333333333e-03; sp = sp * r2 - 1.6666666666666666e-01; const double sn = r + r * r2 * sp;
    double cp = 4.7794773323873853e-14; cp = cp * r2 - 1.1470745597729725e-11; cp = cp * r2 + 2.0876756987868099e-09; cp = cp * r2 - 2.7557319223985888e-07;
    cp = cp * r2 + 2.4801587301587302e-05; cp = cp * r2 - 1.3888888888888889e-03; cp = cp * r2 + 4.1666666666666664e-02; cp = cp * r2 - 0.5; const double cn = 1.0 + r2 * cp;
    const int q = ((int)kq) & 3;
    const double cc = (q == 0) ? cn : (q == 1) ? -sn : (q == 2) ? -cn : sn;
    const double ss = (q == 0) ? sn : (q == 1) ? cn : (q == 2) ? -sn : -cn;
    c = (float)cc; s = (float)ss;
}
#define CONV_DESC(d, it_) ConvItem d; { int r = (it_); \
    if (r < I_2) { d.W = w2s; d.K = DFF; d.N = DM; d.WT = (bf16_t*)(wl + W_2); d.rscale = nullptr; d.rmask = 0; d.mulc = 1.0f; d.perm = false; } \
    else if ((r -= I_2) < I_1) { d.W = w1s; d.K = DM; d.N = DFF; d.WT = (bf16_t*)(wl + W_1); d.rscale = g_mlp; d.rmask = DM - 1; d.mulc = 1.0f; d.perm = false; } \
    else if ((r -= I_1) < I_SQ) { d.W = wos; d.K = DM; d.N = DM; d.WT = (bf16_t*)(wl + W_OUT); d.rscale = nullptr; d.rmask = 0; d.mulc = 1.0f; d.perm = false; } \
    else if ((r -= I_SQ) < I_SQ) { d.W = wds; d.K = DM; d.N = DM; d.WT = (bf16_t*)(wl + W_DO); d.rscale = g_sub; d.rmask = DV2 - 1; d.mulc = oml; d.perm = false; } \
    else if ((r -= I_SQ) < I_SQ) { d.W = wrs; d.K = DM; d.N = DM; d.WT = (bf16_t*)(wl + W_RO); d.rscale = g_gn; d.rmask = DM - 1; d.mulc = 1.0f; d.perm = false; } \
    else { r -= I_SQ; d.W = wis; d.K = DM; d.N = INC; d.WT = (bf16_t*)(wl + W_IN); d.rscale = g_mix; d.rmask = DM - 1; d.mulc = 1.0f; d.perm = true; } \
    const int nblk = d.N / 64; d.k0 = 64 * (r / nblk); d.n0 = 64 * (r % nblk); \
    d.perm = d.perm && (d.n0 < 2048 || (d.n0 >= 6144 && d.n0 < 10240)); }
__device__ __forceinline__ void conv_layer(Frame& F, const Args& A, int l) {
    LAS float* scr = (LAS float*)(F.lds + F.wave * 17408);
    const int gw = blockIdx.x * NWAVES + F.wave, NGW = F.G * NWAVES, ln = lane_id() & 63;
    constexpr int I_IN = (DM / 64) * (INC / 64), I_SQ = (DM / 64) * (DM / 64), I_1 = (DM / 64) * (DFF / 64), I_2 = (DFF / 64) * (DM / 64);
    constexpr int I_LAYER = I_IN + 3 * I_SQ + I_1 + I_2;
    unsigned char* wl = F.ws + WS_W + (size_t)l * W_LAYER;
    const float* w2s = A.in[15] + (size_t)l * DFF * DM; const float* w1s = A.in[14] + (size_t)l * DM * DFF; const float* wos = A.in[12] + (size_t)l * DM * DM;
    const float* wds = A.in[11] + (size_t)l * DM * DM; const float* wrs = A.in[6] + (size_t)l * DM * DM; const float* wis = A.in[2] + (size_t)l * DM * INC;
    const float* g_mlp = A.in[13] + l * DM; const float* g_sub = A.in[10] + l * DV2; const float* g_gn = A.in[5] + l * DM; const float* g_mix = A.in[1] + l * DM; const float oml = A.om_lam_init[l];
    f32x4 va[16], vb[16]; int i0 = gw, i1 = gw + NGW;
    if (i0 < I_LAYER) { CONV_DESC(d, i0); conv_load(d, va, ln); }
    while (i0 < I_LAYER) {
        if (i1 < I_LAYER) { CONV_DESC(d, i1); conv_load(d, vb, ln); }
        { CONV_DESC(d, i0); conv_store(d, va, scr, ln); }
        i0 = i1 + NGW;
        if (i1 >= I_LAYER) break;
        if (i0 < I_LAYER) { CONV_DESC(d, i0); conv_load(d, va, ln); }
        { CONV_DESC(d, i1); conv_store(d, vb, scr, ln); }
        i1 = i0 + NGW;
    }
}
#undef CONV_DESC
__device__ __forceinline__ void p0_prologue(Frame& F, const Args& A) {
    const int gw = blockIdx.x * NWAVES + F.wave, NGW = F.G * NWAVES;
    conv_layer(F, A, 0);
    {
        const float* x = A.in[0]; bf16_t* xb = WSP(bf16_t, WS_XB); float* ssqp = WSP(float, WS_SSQP);
        for (int m = gw; m < L; m += NGW) {
            const f32x4* xr = (const f32x4*)(x + (size_t)m * DM) + F.lane; float s = 0.f;
            unsigned long long* o8 = (unsigned long long*)(xb + (size_t)m * DM) + F.lane;
#pragma unroll
            for (int j = 0; j < 8; ++j) { const f32x4 v = xr[64 * j]; s += (v[0] * v[0] + v[1] * v[1]) + (v[2] * v[2] + v[3] * v[3]);
                o8[64 * j] = (unsigned long long)pk2(v[0], v[1]) | ((unsigned long long)pk2(v[2], v[3]) << 32); }
            s = wave_sum(s);
            if (F.lane < 32) ssqp[(size_t)m * 32 + F.lane] = F.lane == 0 ? s : 0.f;
        }
    }
    {
        float* cs = WSP(float, WS_ROPE);
        for (int p = gw; p < L; p += NGW) { const float ang = (float)p * A.inv[F.lane]; float c, s; sincos_f32angle(ang, c, s);
            *(float2*)(cs + ((size_t)p * 64 + F.lane) * 2) = make_float2(c, s); }
    }
    if (blockIdx.x == 0 && F.wave < NLAYER) {
        const int l = F.wave; const float* lp = A.in[9] + l * 4 * HD; const float* qw = A.in[7] + l * HD; const float* kw = A.in[8] + l * HD;
        float s01 = 0.f, s23 = 0.f, mq = 0.f, mk = 0.f;
        for (int i = F.lane; i < HD; i += 64) { s01 += lp[i] * lp[HD + i]; s23 += lp[2 * HD + i] * lp[3 * HD + i]; mq = fmaxf(mq, fabsf(qw[i])); mk = fmaxf(mk, fabsf(kw[i])); }
        s01 = wave_sum(s01); s23 = wave_sum(s23);
        mq = wave_max(mq); mk = wave_max(mk);
        if (F.lane < 2 * NH) { const int dir = F.lane >> 3, h = F.lane & 7; WSP(float, WS_CONST)[8 + (l * 2 + dir) * NH + h] = log2_gamma_calc((dir ? A.in[4] : A.in[3]) + l * NH + h); }
        if (F.lane == 0) { float* cst = WSP(float, WS_CONST); cst[l] = expf(s01) - expf(s23) + A.lam_init[l];
            cst[4 + l] = 128.0f * mq * mk * 0.12751743082459868f; }
    }
}

constexpr int TP = 136;
#define LG2G(F, layer, dir, h) (WSP(float, WS_CONST)[8 + ((layer) * 2 + (dir)) * NH + (h)])
__device__ __forceinline__ void phase_r1(Frame& F, const Args& A, int layer) {
    LAS bf16_t* KtF = (LAS bf16_t*)F.lds; LAS bf16_t* KtB = KtF + 128 * TP; LAS bf16_t* Vt = KtB + 128 * TP;
    const int wid = F.wave;
    const bf16_t* KR = WSP(bf16_t, WS_KR); const bf16_t* VR = WSP(bf16_t, WS_VR);
    for (int u = blockIdx.x; u < NCH * NH; u += F.G) {
        const int cc = u >> 3, h = u & 7;
        const float lgf = LG2G(F, layer, 0, h), lgb = LG2G(F, layer, 1, h);
        const int tid_o = (F.wave * 64 + (lane_id() & 63)), r32 = tid_o & 31, hi = (tid_o >> 5) & 1;
        __syncthreads();
        v4u kq[4], vq[8];
#pragma unroll
        for (int i = 0; i < 4; ++i) { const int q = tid_o + 512 * i, pos = q & 127, d0 = (q >> 7) * 8; kq[i] = *(const GAS v4u*)(KR + (size_t)(cc * CH + pos) * 1024 + h * HD + d0); }
#pragma unroll
        for (int i = 0; i < 8; ++i) { const int q = tid_o + 512 * i, pos = q & 127, d0 = (q >> 7) * 8; vq[i] = *(const GAS v4u*)(VR + (size_t)(cc * CH + pos) * DM + h * DV2 + d0); }
#pragma unroll
        for (int i = 0; i < 4; ++i) { const int q = tid_o + 512 * i, pos = q & 127, d0 = (q >> 7) * 8;
            const v4u v = kq[i];
            const float wf = __builtin_amdgcn_exp2f((float)(127 - pos) * lgf), wb = __builtin_amdgcn_exp2f((float)pos * lgb);
            const float e[8] = {bflo(v.x), bfhi(v.x), bflo(v.y), bfhi(v.y), bflo(v.z), bfhi(v.z), bflo(v.w), bfhi(v.w)};
#pragma unroll
            for (int k = 0; k < 8; ++k) { KtF[(d0 + k) * TP + pos] = (bf16_t)f2bf(e[k] * wf); KtB[(d0 + k) * TP + pos] = (bf16_t)f2bf(e[k] * wb); } }
#pragma unroll
        for (int i = 0; i < 8; ++i) { const int q = tid_o + 512 * i, pos = q & 127, d0 = (q >> 7) * 8;
            const v4u v = vq[i];
            const unsigned w[4] = {v.x, v.y, v.z, v.w};
#pragma unroll
            for (int k = 0; k < 4; ++k) { Vt[(d0 + 2 * k) * TP + pos] = (bf16_t)(w[k] & 0xffffu); Vt[(d0 + 2 * k + 1) * TP + pos] = (bf16_t)(w[k] >> 16); } }
        __syncthreads();
#pragma unroll
        for (int dir = 0; dir < 2; ++dir) {
            const LAS bf16_t* Kt = dir ? KtB : KtF;
            f32x16 acc[4];
#pragma unroll
            for (int n = 0; n < 4; ++n)
#pragma unroll
                for (int r = 0; r < 16; ++r) acc[n][r] = 0.f;
#pragma unroll 2
            for (int ks = 0; ks < 8; ++ks) {
                const bf16x8 a = *(const LAS bf16x8*)(Vt + (32 * wid + r32) * TP + ks * 16 + hi * 8);
#pragma unroll
                for (int n = 0; n < 4; ++n) { const bf16x8 b = *(const LAS bf16x8*)(Kt + (32 * n + r32) * TP + ks * 16 + hi * 8);
                    acc[n] = __builtin_amdgcn_mfma_f32_32x32x16_bf16(a, b, acc[n], 0, 0, 0); }
            }
            bf16_t* out = (dir ? WSP(bf16_t, WS_KVB) : WSP(bf16_t, WS_KVF)) + ((size_t)(cc * NH + h) * DV2 + 32 * wid) * HD;
#pragma unroll
            for (int n = 0; n < 4; ++n)
#pragma unroll
                for (int r = 0; r < 16; ++r) ((GAS bf16_t*)out)[crow(r, hi) * HD + 32 * n + r32] = (bf16_t)f2bf(acc[n][r]);
        }
    }
}
__device__ __forceinline__ void phase_r2(Frame& F, const Args& A, int layer) {
    constexpr int PER_DIR = NH * DV2 * HD / 4;
    constexpr size_t CSTR = (size_t)NH * DV2 * HD;
    for (int gid = blockIdx.x * 512 + (F.wave * 64 + (lane_id() & 63)); gid < 2 * PER_DIR; gid += F.G * 512) {
        const int dir = gid >= PER_DIR, e4 = gid - dir * PER_DIR, h = e4 / (DV2 * HD / 4);
        const float lg = LG2G(F, layer, dir, h), Gm = __builtin_amdgcn_exp2f(128.0f * lg);
        const bf16_t* kv = (dir ? WSP(bf16_t, WS_KVB) : WSP(bf16_t, WS_KVF)) + (size_t)e4 * 4;
        bf16_t* st = (dir ? WSP(bf16_t, WS_STB) : WSP(bf16_t, WS_STF)) + (size_t)e4 * 4;
        f32x4 s = {0.f, 0.f, 0.f, 0.f};
#pragma unroll 8
        for (int i = 0; i < NCH; ++i) { const int c = dir ? (NCH - 1 - i) : i;
            const v2u vw = *(const v2u*)(kv + (size_t)c * CSTR); const f32x4 v = {bflo(vw.x), bfhi(vw.x), bflo(vw.y), bfhi(vw.y)};
            v2u o; o.x = cvtpk(s[0], s[1]); o.y = cvtpk(s[2], s[3]); *(v2u*)(st + (size_t)c * CSTR) = o;
            s = s * Gm + v; }
    }
}
__device__ __forceinline__ bf16x8 scale_bf8(bf16x8 q, float a) {
    v4u w = __builtin_bit_cast(v4u, q), o;
    o.x = cvtpk(bflo(w.x) * a, bfhi(w.x) * a); o.y = cvtpk(bflo(w.y) * a, bfhi(w.y) * a); o.z = cvtpk(bflo(w.z) * a, bfhi(w.z) * a); o.w = cvtpk(bflo(w.w) * a, bfhi(w.w) * a);
    return __builtin_bit_cast(bf16x8, o);
}
__device__ __forceinline__ void phase_r3(Frame& F, const Args& A, int layer) {
    LAS bf16_t* Ks = (LAS bf16_t*)F.lds; LAS bf16_t* Vt = Ks + 128 * TP;
    const int wid = F.wave;
    const bf16_t* QR = WSP(bf16_t, WS_QR); const bf16_t* KR = WSP(bf16_t, WS_KR); const bf16_t* VR = WSP(bf16_t, WS_VR); const bf16_t* GR = WSP(bf16_t, WS_GR);
    bf16_t* UR = WSP(bf16_t, WS_URET);
    for (int u = blockIdx.x; u < NCH * NH; u += F.G) {
        const int cc = u >> 3, h = u & 7;
        const int tid_o = (F.wave * 64 + (lane_id() & 63)), lane_o = tid_o & 63, c16 = lane_o & 15, g = lane_o >> 4;
        const float lgf = LG2G(F, layer, 0, h), lgb = LG2G(F, layer, 1, h);
        __syncthreads();
        v4u kq[4], vq[8];
#pragma unroll
        for (int i = 0; i < 4; ++i) { const int q = tid_o + 512 * i, row = q >> 4, ch = q & 15; kq[i] = *(const GAS v4u*)(KR + (size_t)(cc * CH + row) * 1024 + h * HD + ch * 8); }
#pragma unroll
        for (int i = 0; i < 8; ++i) { const int q = tid_o + 512 * i, pos = q & 127, d0 = (q >> 7) * 8; vq[i] = *(const GAS v4u*)(VR + (size_t)(cc * CH + pos) * DM + h * DV2 + d0); }
#pragma unroll
        for (int i = 0; i < 4; ++i) { const int q = tid_o + 512 * i, row = q >> 4, ch = q & 15; *(LAS v4u*)(Ks + row * TP + ch * 8) = kq[i]; }
#pragma unroll
        for (int i = 0; i < 8; ++i) { const int q = tid_o + 512 * i, pos = q & 127, d0 = (q >> 7) * 8;
            const v4u v = vq[i];
            const unsigned w[4] = {v.x, v.y, v.z, v.w};
#pragma unroll
            for (int k = 0; k < 4; ++k) { Vt[(d0 + 2 * k) * TP + pos] = (bf16_t)(w[k] & 0xffffu); Vt[(d0 + 2 * k + 1) * TP + pos] = (bf16_t)(w[k] >> 16); } }
        __syncthreads();
        const int pos_i = 16 * wid + c16; const size_t gpos = (size_t)cc * CH + pos_i;
        bf16x8 qf[4];
#pragma unroll
        for (int s = 0; s < 4; ++s) qf[s] = *(const GAS bf16x8*)(QR + gpos * 1024 + h * HD + 32 * s + 8 * g);
        f32x4 st[8];
#pragma unroll
        for (int b = 0; b < 8; ++b) { st[b] = (f32x4){0.f, 0.f, 0.f, 0.f};
#pragma unroll
            for (int s = 0; s < 4; ++s) { const bf16x8 a = *(const LAS bf16x8*)(Ks + (16 * b + c16) * TP + 32 * s + 8 * g);
                st[b] = __builtin_amdgcn_mfma_f32_16x16x32_bf16(a, qf[s], st[b], 0, 0, 0); } }
#pragma unroll
        for (int b = 0; b < 8; ++b)
#pragma unroll
            for (int r = 0; r < 4; ++r) { const int d = pos_i - (16 * b + 4 * g + r);
                const float m = d > 0 ? __builtin_amdgcn_exp2f((float)d * lgf) : (d < 0 ? __builtin_amdgcn_exp2f((float)(-d) * lgb) : 2.0f);
                st[b][r] *= m; }
        f32x4 R[16];
#pragma unroll
        for (int n = 0; n < 16; ++n) R[n] = (f32x4){0.f, 0.f, 0.f, 0.f};
#pragma unroll
        for (int s2 = 0; s2 < 4; ++s2) {
            v4u pw; pw.x = cvtpk(st[2 * s2][0], st[2 * s2][1]); pw.y = cvtpk(st[2 * s2][2], st[2 * s2][3]); pw.z = cvtpk(st[2 * s2 + 1][0], st[2 * s2 + 1][1]); pw.w = cvtpk(st[2 * s2 + 1][2], st[2 * s2 + 1][3]);
            const bf16x8 pa = __builtin_bit_cast(bf16x8, pw);
#pragma unroll
            for (int n = 0; n < 16; ++n) {
                const v2u lo = *(const LAS v2u*)(Vt + (16 * n + c16) * TP + 32 * s2 + 4 * g), hi4 = *(const LAS v2u*)(Vt + (16 * n + c16) * TP + 32 * s2 + 16 + 4 * g);
                v4u bw; bw.x = lo.x; bw.y = lo.y; bw.z = hi4.x; bw.w = hi4.y;
                R[n] = __builtin_amdgcn_mfma_f32_16x16x32_bf16(pa, __builtin_bit_cast(bf16x8, bw), R[n], 0, 0, 0);
            }
            asm volatile("" ::: "memory");
        }
#pragma unroll
        for (int dir = 0; dir < 2; ++dir) {
            const float asc = dir ? __builtin_amdgcn_exp2f((float)(CH - pos_i) * lgb) : __builtin_amdgcn_exp2f((float)(pos_i + 1) * lgf);
            const GAS bf16_t* ST = (const GAS bf16_t*)((dir ? WSP(bf16_t, WS_STB) : WSP(bf16_t, WS_STF)) + (size_t)(cc * NH + h) * DV2 * HD) + c16 * HD + 8 * g;
#pragma unroll
            for (int s = 0; s < 4; ++s) { const bf16x8 qs = scale_bf8(qf[s], asc); bf16x8 bq[16];
#pragma unroll
                for (int n = 0; n < 16; ++n) bq[n] = *(const GAS bf16x8*)(ST + n * (16 * HD) + 32 * s);
#pragma unroll
                for (int n = 0; n < 16; ++n) R[n] = __builtin_amdgcn_mfma_f32_16x16x32_bf16(qs, bq[n], R[n], 0, 0, 0);
                asm volatile("" ::: "memory"); }
        }
#pragma unroll
        for (int r = 0; r < 4; ++r) {
            float s = 0.f;
#pragma unroll
            for (int n = 0; n < 16; ++n) s += R[n][r];
            s = sum16(s);
            const float mean = s * (1.0f / DV2); float q = 0.f;
#pragma unroll
            for (int n = 0; n < 16; ++n) { const float d = R[n][r] - mean; q += d * d; }
            q = sum16(q);
            const float rstd = __builtin_amdgcn_rsqf(q * (1.0f / DV2) + GN_EPS);
            int c16o = c16; asm volatile("" : "+v"(c16o) : "v"(rstd));
            const size_t ro = ((size_t)cc * CH + 16 * wid + 4 * g + r) * DM + h * DV2 + (c16o & 15);
            const GAS bf16_t* gp = (const GAS bf16_t*)(GR + ro); GAS bf16_t* up = (GAS bf16_t*)(UR + ro);
#pragma unroll
            for (int n = 0; n < 16; ++n) up[16 * n] = (bf16_t)f2bf((R[n][r] - mean) * rstd * bf2f(gp[16 * n]));
            asm volatile("" ::: "memory");
        }
    }
}

constexpr int AK_BYTES = 16384, AV_BYTES = 32768, AV_OFF = 2 * AK_BYTES, ASCR_OFF = AV_OFF + 3 * AV_BYTES;
#define KSWZ(row, colB) ((row) * 256 + ((colB) ^ (((row) & 15) << 4)))
__device__ __forceinline__ int v_rd_base(int lane) { const int g = lane >> 4, qq = (lane >> 2) & 3, p = lane & 3, x = (2 * (g & 1) + (g >> 1)) & 3;
    return 4096 * (g & 1) + 64 * (4 * (g >> 1) + qq) + 16 * ((p >> 1) ^ x) + 8 * (p & 1); }
constexpr int v_rd_off(int e, int m, int hh) { return 16384 * m + 8192 * hh + 512 * e; }
template <int OFF> __device__ __forceinline__ s16x4 tr_read(int vb) {
    s16x4 r; asm volatile("ds_read_b64_tr_b16 %0, %1 offset:%2" : "=&v"(r) : "v"(vb), "i"(OFF) : "memory"); return r;
}
struct VFrag { s16x4 a0, a1, a2, a3; };
template <int D> __device__ __forceinline__ void pv_reads(VFrag& f, int vb, int vc) {
    const int v = (D & 1) ? vc : vb;
    f.a0 = tr_read<v_rd_off(D >> 1, 0, 0)>(v); f.a1 = tr_read<v_rd_off(D >> 1, 0, 1)>(v); f.a2 = tr_read<v_rd_off(D >> 1, 1, 0)>(v); f.a3 = tr_read<v_rd_off(D >> 1, 1, 1)>(v);
}
#define MFA(ACC, REG, Ax, Bx) asm volatile("v_mfma_f32_16x16x32_bf16 %0, %1, %2, %0" : "+{" REG "}"(ACC) : "v"(Ax), "v"(Bx))
#define PKV(Lx, Hx) (bf16x8){Lx[0], Lx[1], Lx[2], Lx[3], Hx[0], Hx[1], Hx[2], Hx[3]}
#define PV_MMA(D, R0, R1, Fx) do { const bf16x8 lo_ = PKV(Fx.a0, Fx.a1), hi_ = PKV(Fx.a2, Fx.a3); \
    MFA(o[D][0], R0, lo_, pb00); MFA(o[D][1], R1, lo_, pb01); MFA(o[D][0], R0, hi_, pb10); MFA(o[D][1], R1, hi_, pb11); } while (0)
#define PV_WAIT12() do { asm volatile("s_waitcnt lgkmcnt(12)" ::: "memory"); SBAR(); } while (0)
#define PV_WAIT4() do { asm volatile("s_waitcnt lgkmcnt(4)" ::: "memory"); SBAR(); } while (0)
#define PV_WAIT8() do { asm volatile("s_waitcnt lgkmcnt(8)" ::: "memory"); SBAR(); } while (0)
#define PV_WAIT0() do { asm volatile("s_waitcnt lgkmcnt(0)" ::: "memory"); SBAR(); } while (0)
__device__ __forceinline__ void phase_attn(Frame& F, const Args& A, int layer) {
    const int lane = (lane_id() & 63), wid = F.wave, c16 = lane & 15, gq = lane >> 4;
    const int pr = (c16 & 3) | ((c16 & 4) << 1) | ((c16 & 8) >> 1);
    LAS unsigned char* Kl = F.lds; LAS unsigned char* Vl = F.lds + AV_OFF;
    const float lam = WSP(float, WS_CONST)[layer], Bs = WSP(float, WS_CONST)[4 + layer];
    const bf16_t* DQ = WSP(bf16_t, WS_DQ); const bf16_t* DK = WSP(bf16_t, WS_DK); const bf16_t* DV = WSP(bf16_t, WS_DV); bf16_t* OD = WSP(bf16_t, WS_ODIFF);
    for (int u = blockIdx.x; u < NH * (L / 256); u += F.G) {
        const int h = u & 7, qb = u >> 3;
        const int ld_ = opaque(lane) & 63; unsigned koff[2], voff;
#pragma unroll
        for (int i = 0; i < 2; ++i) { const int p = 2 * wid + i, row = 4 * p + (ld_ >> 4), c = (ld_ & 15) ^ (row & 15); koff[i] = (unsigned)(row * DM + c * 8) * 2u; }
        { const int s = 8 * wid + (ld_ >> 5), kg = s >> 3, cb = s & 7, rin = (ld_ & 31) >> 2, row = 8 * kg + rin;
            const int chlo = (ld_ & 3) ^ ((row >> 2) & 3); voff = (unsigned)(row * DM + cb * 32 + chlo * 8) * 2u; }
#pragma unroll 1
        for (int t = 0; t < 2; ++t) {
            int lq = lane; asm volatile("" : "+v"(lq));
            const bf16_t* Qp = DQ + (size_t)(qb * 256 + wid * 32 + (lq & 15)) * DM + (h * 2 + t) * HD + (lq >> 4) * 8;
            bf16x8 qr[2][4];
#pragma unroll
            for (int q2 = 0; q2 < 2; ++q2)
#pragma unroll
                for (int ds = 0; ds < 4; ++ds) qr[q2][ds] = *(const GAS bf16x8*)(Qp + (size_t)q2 * 16 * DM + ds * 32);
            const char* Kg = (const char*)(DK + (h * 2 + t) * HD); const char* Vg = (const char*)(DV + h * DV2);
#define ATT_DMA_K(j, b) do { const char* kb_ = Kg + (size_t)(j) * (64 * DM * 2); \
            _Pragma("unroll") for (int i_ = 0; i_ < 2; ++i_) { unsigned ko_ = koff[i_]; asm volatile("" : "+v"(ko_)); __builtin_amdgcn_global_load_lds((const unsigned*)(kb_ + ko_), (LAS unsigned*)(Kl + (b) * AK_BYTES + (2 * wid + i_) * 1024), 16, 0, 0); } } while (0)
#define ATT_DMA_V(j, b) do { const char* vb_ = Vg + (size_t)(j) * (64 * DM * 2); \
            _Pragma("unroll") for (int i_ = 0; i_ < 4; ++i_) { unsigned vo_ = voff; asm volatile("" : "+v"(vo_)); __builtin_amdgcn_global_load_lds((const unsigned*)(vb_ + 128 * i_ + vo_), (LAS unsigned*)(Vl + (b) * AV_BYTES + (4 * wid + i_) * 1024), 16, 0, 0); } } while (0)
            constexpr float C2 = 0.12751743082459868f;
#define MF16(Ax, Bx, Cx) Cx = __builtin_amdgcn_mfma_f32_16x16x32_bf16(Ax, Bx, Cx, 0, 0, 0)
#define PKB(OUT, X, Y) do { v4u w_; w_.x = cvtpk(X[0], X[1]); w_.y = cvtpk(X[2], X[3]); w_.z = cvtpk(Y[0], Y[1]); w_.w = cvtpk(Y[2], Y[3]); OUT = __builtin_bit_cast(bf16x8, w_); } while (0)
#define QK_MM(A, Q0, Q1, C) \
            "v_mfma_f32_16x16x32_bf16 %[s00], %[" A "0], %[" Q0 "], " C("s00") "\n\tv_mfma_f32_16x16x32_bf16 %[s01], %[" A "0], %[" Q1 "], " C("s01") "\n\t" \
            "v_mfma_f32_16x16x32_bf16 %[s10], %[" A "1], %[" Q0 "], " C("s10") "\n\tv_mfma_f32_16x16x32_bf16 %[s11], %[" A "1], %[" Q1 "], " C("s11") "\n\t" \
            "v_mfma_f32_16x16x32_bf16 %[s20], %[" A "2], %[" Q0 "], " C("s20") "\n\tv_mfma_f32_16x16x32_bf16 %[s21], %[" A "2], %[" Q1 "], " C("s21") "\n\t" \
            "v_mfma_f32_16x16x32_bf16 %[s30], %[" A "3], %[" Q0 "], " C("s30") "\n\tv_mfma_f32_16x16x32_bf16 %[s31], %[" A "3], %[" Q1 "], " C("s31") "\n\t"
#define QK_C0(n) "0"
#define QK_CA(n) "%[" n "]"
#define QK_RD(A, K) "ds_read_b128 %[" A "0], %[" K "]\n\tds_read_b128 %[" A "1], %[" K "] offset:4096\n\tds_read_b128 %[" A "2], %[" K "] offset:8192\n\tds_read_b128 %[" A "3], %[" K "] offset:12288\n\t"
#define ATT_QKSM(b, DMA_STMT) do { const int k0_ = (int)(uintptr_t)Kl + (b) * AK_BYTES + KSWZ(pr, 16 * gq); int kt_;        \
            f32x4 s00, s01, s10, s11, s20, s21, s30, s31; bf16x8 ka0, ka1, ka2, ka3, kc0, kc1, kc2, kc3; \
            asm volatile("s_setprio 2\n\t" \
                QK_RD("a", "k0") "v_xor_b32 %[kt], 64, %[k0]\n\t" QK_RD("c", "kt") \
                "s_waitcnt lgkmcnt(4)\n\t" QK_MM("a", "q00", "q10", QK_C0) "v_xor_b32 %[kt], 0x80, %[k0]\n\t" QK_RD("a", "kt") \
                "s_waitcnt lgkmcnt(4)\n\t" QK_MM("c", "q01", "q11", QK_CA) "v_xor_b32 %[kt], 0xc0, %[k0]\n\t" QK_RD("c", "kt") \
                "s_waitcnt lgkmcnt(4)\n\t" QK_MM("a", "q02", "q12", QK_CA) \
                "s_waitcnt lgkmcnt(0)\n\t" QK_MM("c", "q03", "q13", QK_CA) \
                "s_setprio 0\n\ts_nop 10" \
                : [s00] "=&v"(s00), [s01] "=&v"(s01), [s10] "=&v"(s10), [s11] "=&v"(s11), [s20] "=&v"(s20), [s21] "=&v"(s21), [s30] "=&v"(s30), [s31] "=&v"(s31), \
                  [a0] "=&v"(ka0), [a1] "=&v"(ka1), [a2] "=&v"(ka2), [a3] "=&v"(ka3), [c0] "=&v"(kc0), [c1] "=&v"(kc1), [c2] "=&v"(kc2), [c3] "=&v"(kc3), [kt] "=&v"(kt_) \
                : [k0] "v"(k0_), \
                  [q00] "v"(qr[0][0]), [q01] "v"(qr[0][1]), [q02] "v"(qr[0][2]), [q03] "v"(qr[0][3]), [q10] "v"(qr[1][0]), [q11] "v"(qr[1][1]), [q12] "v"(qr[1][2]), [q13] "v"(qr[1][3]) \
                : "memory"); \
            DMA_STMT; \
            float ps0 = 0.f, ps1 = 0.f; \
            _Pragma("unroll") for (int r = 0; r < 4; ++r) { \
                s00[r] = __builtin_amdgcn_exp2f(fmaf(s00[r], C2, -Bs)); s10[r] = __builtin_amdgcn_exp2f(fmaf(s10[r], C2, -Bs)); s20[r] = __builtin_amdgcn_exp2f(fmaf(s20[r], C2, -Bs)); s30[r] = __builtin_amdgcn_exp2f(fmaf(s30[r], C2, -Bs)); \
                s01[r] = __builtin_amdgcn_exp2f(fmaf(s01[r], C2, -Bs)); s11[r] = __builtin_amdgcn_exp2f(fmaf(s11[r], C2, -Bs)); s21[r] = __builtin_amdgcn_exp2f(fmaf(s21[r], C2, -Bs)); s31[r] = __builtin_amdgcn_exp2f(fmaf(s31[r], C2, -Bs)); \
                ps0 += (s00[r] + s10[r]) + (s20[r] + s30[r]); ps1 += (s01[r] + s11[r]) + (s21[r] + s31[r]); } \
            l0 += ps0; l1 += ps1; asm volatile("" : "+v"(l0), "+v"(l1));        \
            PKB(pb00, s00, s10); PKB(pb01, s01, s11); PKB(pb10, s20, s30); PKB(pb11, s21, s31); } while (0)
#define ATT_PV(b, DMA_STMT) do { const int vl_ = v_rd_base(lane_id() & 63), vb_ = (int)(uintptr_t)Vl + (b) * AV_BYTES + vl_, vc_ = (int)(uintptr_t)Vl + (b) * AV_BYTES + (vl_ ^ 32); VFrag fa_, fb_, fc_, fd_; \
            pv_reads<0>(fa_, vb_, vc_); pv_reads<1>(fb_, vb_, vc_); pv_reads<2>(fc_, vb_, vc_); \
            pv_reads<3>(fd_, vb_, vc_); PV_WAIT12(); PV_MMA(0, "v[124:127]", "v[128:131]", fa_); \
            pv_reads<4>(fa_, vb_, vc_); PV_WAIT12(); PV_MMA(1, "v[132:135]", "v[136:139]", fb_); \
            pv_reads<5>(fb_, vb_, vc_); PV_WAIT12(); PV_MMA(2, "v[140:143]", "v[144:147]", fc_); \
            pv_reads<6>(fc_, vb_, vc_); PV_WAIT12(); PV_MMA(3, "v[148:151]", "v[152:155]", fd_); \
            pv_reads<7>(fd_, vb_, vc_); PV_WAIT12(); PV_MMA(4, "v[156:159]", "v[160:163]", fa_); \
            pv_reads<8>(fa_, vb_, vc_); PV_WAIT12(); PV_MMA(5, "v[164:167]", "v[168:171]", fb_); \
            pv_reads<9>(fb_, vb_, vc_); PV_WAIT12(); PV_MMA(6, "v[172:175]", "v[176:179]", fc_); \
            pv_reads<10>(fc_, vb_, vc_); PV_WAIT12(); PV_MMA(7, "v[180:183]", "v[184:187]", fd_); \
            DMA_STMT; \
            pv_reads<11>(fd_, vb_, vc_); PV_WAIT12(); PV_MMA(8, "v[188:191]", "v[192:195]", fa_); \
            pv_reads<12>(fa_, vb_, vc_); PV_WAIT12(); PV_MMA(9, "v[196:199]", "v[200:203]", fb_); \
            pv_reads<13>(fb_, vb_, vc_); PV_WAIT12(); PV_MMA(10, "v[204:207]", "v[208:211]", fc_); \
            pv_reads<14>(fc_, vb_, vc_); PV_WAIT12(); PV_MMA(11, "v[212:215]", "v[216:219]", fd_); \
            pv_reads<15>(fd_, vb_, vc_); PV_WAIT12(); PV_MMA(12, "v[220:223]", "v[224:227]", fa_); \
            PV_WAIT8(); PV_MMA(13, "v[228:231]", "v[232:235]", fb_); \
            PV_WAIT4(); PV_MMA(14, "v[236:239]", "v[240:243]", fc_); \
            PV_WAIT0(); PV_MMA(15, "v[244:247]", "v[248:251]", fd_); } while (0)
            f32x4 o[16][2];
#pragma unroll
            for (int d = 0; d < 16; ++d)
#pragma unroll
                for (int r = 0; r < 4; ++r) { o[d][0][r] = 0.f; o[d][1][r] = 0.f; }
            float l0 = 0.f, l1 = 0.f; bf16x8 pb00, pb01, pb10, pb11;
            constexpr int NT = L / 64;
#define ATT_TSYNC() do { asm volatile("s_waitcnt vmcnt(0)" ::: "memory"); asm volatile("s_waitcnt lgkmcnt(0)" ::: "memory"); __builtin_amdgcn_s_barrier(); asm volatile("" ::: "memory"); } while (0)
            __syncthreads();
            ATT_DMA_K(0, 0); ATT_DMA_V(0, 0); VM_WAIT(); __syncthreads();
            if (wid < 4) {
                int v3 = 0;
#pragma unroll 1
                for (int j = 0; j < NT; ++j) { const int b = j & 1, vn = v3 == 2 ? 0 : v3 + 1, jn = j + 1 < NT ? j + 1 : NT - 1;
                    ATT_QKSM(b, ATT_DMA_K(jn, b ^ 1)); SBAR(); asm volatile("" ::: "memory");
                    ATT_PV(v3, ATT_DMA_V(jn, vn));
                    ATT_TSYNC(); v3 = vn; }
            } else {
                int v3 = 0;
#pragma unroll 1
                for (int j = 0; j < NT; ++j) { const int b = j & 1, vn = v3 == 2 ? 0 : v3 + 1, vp = v3 == 0 ? 2 : v3 - 1, jn = j + 1 < NT ? j + 1 : NT - 1;
                    ATT_DMA_V(jn, vn);
                    if (j > 0) ATT_PV(vp, (void)0);
                    SBAR(); asm volatile("" ::: "memory");
                    ATT_QKSM(b, ATT_DMA_K(jn, b ^ 1));
                    ATT_TSYNC(); v3 = vn; }
                ATT_PV((NT - 1) % 3, (void)0); asm volatile("s_waitcnt lgkmcnt(0)" ::: "memory");
            }
#undef ATT_TSYNC
#undef ATT_DMA_K
#undef ATT_DMA_V
#undef ATT_QKSM
#undef ATT_PV
#undef PKB
#undef MFA
#undef PKV
#undef PV_MMA
#undef MF16
#undef QK_MM
#undef QK_C0
#undef QK_CA
#undef QK_RD
            int le = lane; asm volatile("" : "+v"(le));
            const int c16e = le & 15, ge = le >> 4;
            float rl0, rl1;
            { float a0 = l0 + sw_xor<16>(l0), a1 = l1 + sw_xor<16>(l1); a0 = add_xor32(a0); a1 = add_xor32(a1); rl0 = __builtin_amdgcn_rcpf(a0); rl1 = __builtin_amdgcn_rcpf(a1); }
            GAS float* sp = (GAS float*)(WSP(float, WS_ATT) + ((size_t)(u * NWAVES + wid) * 128) * 64 + le);
            if (t == 0) {
#pragma unroll
                for (int d = 0; d < 16; ++d) {
#pragma unroll
                    for (int r = 0; r < 4; ++r) { sp[((d * 2 + 0) * 4 + r) * 64] = o[d][0][r] * rl0; sp[((d * 2 + 1) * 4 + r) * 64] = o[d][1][r] * rl1; }
                    asm volatile("" ::: "memory"); SBAR(); }
            } else {
                float ss0 = 0.f, ss1 = 0.f; const float lr0 = lam * rl0, lr1 = lam * rl1;
                float ta[8], tb[8];
#define EP_LD(T, D) _Pragma("unroll") for (int r = 0; r < 4; ++r) { T[r] = sp[(((D) * 2 + 0) * 4 + r) * 64]; T[4 + r] = sp[(((D) * 2 + 1) * 4 + r) * 64]; }
#define EP_CP(T, D) _Pragma("unroll") for (int r = 0; r < 4; ++r) { const float v0 = T[r] - lr0 * o[D][0][r]; ss0 += v0 * v0; sp[(((D) * 2 + 0) * 4 + r) * 64] = v0; const float v1 = T[4 + r] - lr1 * o[D][1][r]; ss1 += v1 * v1; sp[(((D) * 2 + 1) * 4 + r) * 64] = v1; }
                EP_LD(ta, 0);
#pragma unroll
                for (int d = 0; d < 16; d += 2) { EP_LD(tb, d + 1); SBAR(); EP_CP(ta, d); SBAR(); if (d + 2 < 16) { EP_LD(ta, d + 2); } SBAR(); EP_CP(tb, d + 1); SBAR(); }
#undef EP_CP
                ss0 += sw_xor<16>(ss0); ss1 += sw_xor<16>(ss1); ss0 = add_xor32(ss0); ss1 = add_xor32(ss1);
                ss0 = __builtin_amdgcn_rsqf(ss0 * (1.0f / DV2) + NORM_EPS); ss1 = __builtin_amdgcn_rsqf(ss1 * (1.0f / DV2) + NORM_EPS);
                GAS bf16_t* op = (GAS bf16_t*)(OD + (size_t)(qb * 256 + wid * 32 + c16e) * DM + h * DV2 + 4 * ge);
#define EP_ST(T, D) do { const unsigned w0 = pk2(T[0] * ss0, T[1] * ss0), w1 = pk2(T[2] * ss0, T[3] * ss0), w2 = pk2(T[4] * ss1, T[5] * ss1), w3 = pk2(T[6] * ss1, T[7] * ss1); \
                    *(GAS unsigned long long*)(op + (D) * 16) = (unsigned long long)w0 | ((unsigned long long)w1 << 32); *(GAS unsigned long long*)(op + (size_t)16 * DM + (D) * 16) = (unsigned long long)w2 | ((unsigned long long)w3 << 32); } while (0)
                asm volatile("s_waitcnt vmcnt(0)" ::: "memory");
                EP_LD(ta, 0);
#pragma unroll
                for (int d = 0; d < 16; d += 2) { EP_LD(tb, d + 1); SBAR(); EP_ST(ta, d); SBAR(); if (d + 2 < 16) { EP_LD(ta, d + 2); } SBAR(); EP_ST(tb, d + 1); SBAR(); }
#undef EP_LD
#undef EP_ST
            }
        }
    }
}

constexpr int PH_PER_LAYER = 8, N_PHASES = 1 + NLAYER * PH_PER_LAYER;
__global__ void __launch_bounds__(NWAVES * 64, 2) fwd(Args args) {
    extern __shared__ __attribute__((aligned(16))) unsigned char lds[];
    Frame F;
    F.lds = (LAS unsigned char*)lds; F.ws = args.ws;
    F.wave = __builtin_amdgcn_readfirstlane((int)threadIdx.x >> 6); F.lane = lane_id() & 63; F.tid = F.wave * 64 + F.lane; F.G = gridDim.x;
    volatile LAS unsigned* MISC = (volatile LAS unsigned*)(F.lds + MISC_OFF);
    if (F.tid < 32) MISC[F.tid] = 0u;
    __syncthreads();
    const int lo = args.ph_lo, hi = args.ph_hi;
    unsigned* barw = (unsigned*)(F.ws + WS_CTL) + CW_BAR;
    XcdBarrier bar; bar.bar = barw; bar.x = 0; bar.st = MISC + 8;
    if (hi - lo > 1) bar = xcd_barrier_post(barw, MISC + 8, F.wave == 0 && lane_id() == 0);
#define IN(k) (lo <= (k) && (k) < hi)
#define SEAM(k) do { if (IN(k) && IN((k) + 1)) { XcdBarrier b_ = bar; unsigned* bw_ = b_.bar; asm volatile("" : "+s"(bw_)); b_.bar = bw_; xcd_barrier(b_, F.wave == 0 && lane_id() == 0); } } while (0)
    if (IN(0)) p0_prologue(F, args);
    SEAM(0);
#pragma unroll 1
    for (int l = 0; l < NLAYER; ++l) {
        const int pb = 1 + l * PH_PER_LAYER;
        const Args& A = args;
        { unsigned char* w_ = A.ws; asm volatile("" : "+s"(w_)); F.ws = w_; int t_ = lane_id(); asm volatile("" : "+v"(t_)); F.lane = t_ & 63; F.tid = F.wave * 64 + F.lane; }
        unsigned char* wl = F.ws + WS_W + (size_t)l * W_LAYER;
        float* ssqp = WSP(float, WS_SSQP);
        if (IN(pb + 0)) {
            pg8::Gemm g{WSP(bf16_t, WS_XB), (const bf16_t*)(wl + W_IN), L, INC, DM}; pg8::StaticOrder S; S.init(L, INC, F.G, (int)blockIdx.x);
            Unit u0{4 * ((int)blockIdx.x & 7) + (((int)blockIdx.x >> 3) & 3), 0};        const float* sq = ssqp + (size_t)(2 * l) * L * 32;
            rs_panel_to_lds(F.lds, sq, u0.pm, F.wave * 64 + (lane_id() & 63));
            EpiInProj E{sq, WSP(float, WS_ROPE), F.ws, (LAS float*)(F.lds + 131072), A.in[7] + l * HD, A.in[8] + l * HD, (LAS float*)(F.lds + RS_OFF), u0.pm};
            pg8::gemm_phase<EpiInProj, pg8::StaticOrder, true, true>(F.lds, g, S, E, F.wave);
        }
        SEAM(pb + 0);
        if (IN(pb + 1)) phase_r1(F, A, l);
        SEAM(pb + 1);
        if (IN(pb + 2)) phase_r2(F, A, l);
        SEAM(pb + 2);
        if (IN(pb + 3)) phase_r3(F, A, l);
        if (IN(pb + 3)) phase_attn(F, A, l);
        SEAM(pb + 3);
        if (IN(pb + 4)) {
            { pg8::Gemm g{WSP(bf16_t, WS_URET), (const bf16_t*)(wl + W_RO), L, DM, DM}; pg8::StaticOrder S; S.init(L, DM, F.G, (int)blockIdx.x);
              EpiGateA E{WSP(bf16_t, WS_SGR), WSP(bf16_t, WS_T1)};
              pg8::gemm_phase<EpiGateA, pg8::StaticOrder, true, true>(F.lds, g, S, E, F.wave); }
            VM_WAIT(); __syncthreads();
            { pg8::Gemm g{WSP(bf16_t, WS_ODIFF), (const bf16_t*)(wl + W_DO), L, DM, DM}; pg8::StaticOrder S; S.init(L, DM, F.G, (int)blockIdx.x);
              EpiGateB E{WSP(bf16_t, WS_SGD), WSP(bf16_t, WS_T1), WSP(bf16_t, WS_MERGED)};
              pg8::gemm_phase<EpiGateB, pg8::StaticOrder, true, true>(F.lds, g, S, E, F.wave); }
        }
        SEAM(pb + 4);
        if (IN(pb + 5)) {
            pg8::Gemm g{WSP(bf16_t, WS_MERGED), (const bf16_t*)(wl + W_OUT), L, DM, DM}; pg8::StaticOrder S; S.init(L, DM, F.G, (int)blockIdx.x);
            EpiResid E{nullptr, WSP(bf16_t, WS_XB), ssqp + (size_t)(2 * l + 1) * L * 32};
            pg8::gemm_phase<EpiResid, pg8::StaticOrder, true, true>(F.lds, g, S, E, F.wave);
        }
        SEAM(pb + 5);
        if (IN(pb + 6)) {
            pg8::Gemm g{WSP(bf16_t, WS_XB), (const bf16_t*)(wl + W_1), L, DFF, DM}; pg8::StaticOrder S; S.init(L, DFF, F.G, (int)blockIdx.x);
            Unit u0{4 * ((int)blockIdx.x & 7) + (((int)blockIdx.x >> 3) & 3), 0};        const float* sq = ssqp + (size_t)(2 * l + 1) * L * 32;
            rs_panel_to_lds(F.lds, sq, u0.pm, F.wave * 64 + (lane_id() & 63));
            EpiMlpIn E{sq, WSP(bf16_t, WS_UMLP), (LAS float*)(F.lds + RS_OFF), u0.pm};
            pg8::gemm_phase<EpiMlpIn, pg8::StaticOrder, true, true>(F.lds, g, S, E, F.wave);
        }
        SEAM(pb + 6);
        if (IN(pb + 7)) {
            pg8::Gemm g{WSP(bf16_t, WS_UMLP), (const bf16_t*)(wl + W_2), L, DM, DFF}; pg8::StaticOrder S; S.init(L, DM, F.G, (int)blockIdx.x);
            EpiResid E{l == NLAYER - 1 ? A.out : nullptr, WSP(bf16_t, WS_XB), ssqp + (size_t)(2 * l + 2) * L * 32};
            pg8::gemm_phase<EpiResid, pg8::StaticOrder, true, true>(F.lds, g, S, E, F.wave);
            if (l + 1 < NLAYER) { VM_WAIT(); __syncthreads(); conv_layer(F, A, l + 1); }
        }
        SEAM(pb + 7);
    }
#undef IN
#undef SEAM
}


extern "C" void kernel_launch(void* const* d_in, const int* in_sizes, int n_in, void* d_out, int out_size, void* d_ws, size_t ws_size, hipStream_t stream) {
    static int grid = 0;
    if (grid == 0) {
        if (n_in != 16 || in_sizes[0] != L * DM || out_size != L * DM || ws_size < WS_END) {
            fprintf(stderr, "kernel_launch: shape mismatch: n_in %d in0 %d out %d ws %zu (need >= %zu); nothing launched\n", n_in, n_in > 0 ? in_sizes[0] : -1, out_size, ws_size, (size_t)WS_END); grid = -1; return; }
        int dev = 0, cus = 0;
        if (hipGetDevice(&dev) != hipSuccess || hipDeviceGetAttribute(&cus, hipDeviceAttributeMultiprocessorCount, dev) != hipSuccess) { fprintf(stderr, "kernel_launch: device query failed\n"); grid = -1; return; }
        if (hipFuncSetAttribute((const void*)fwd, hipFuncAttributeMaxDynamicSharedMemorySize, LDS_BYTES) != hipSuccess) { fprintf(stderr, "kernel_launch: hipFuncSetAttribute failed\n"); grid = -1; return; }
        int per_cu = 0;
        if (hipOccupancyMaxActiveBlocksPerMultiprocessor(&per_cu, (const void*)fwd, NWAVES * 64, LDS_BYTES) != hipSuccess || per_cu < 1)
            fprintf(stderr, "kernel_launch: note: occupancy query reports %d workgroups per CU\n", per_cu);
        (void)hipGetLastError();
        if (cus < 256) { fprintf(stderr, "kernel_launch: this kernel needs 256 compute units (found %d); nothing launched\n", cus); grid = -1; return; }
        grid = 256;
    }
    if (grid < 0) return;
    (void)hipMemsetAsync((char*)d_ws + WS_CTL, 0, CTL_ZERO_BYTES, stream);
    Args a{};
    for (int i = 0; i < 16; ++i) a.in[i] = (const float*)d_in[i];
    a.out = (float*)d_out; a.ws = (unsigned char*)d_ws;
    for (int j = 0; j < 64; ++j) { const float pw = (float)std::pow(10000.0, (double)((float)(2 * j) / 128.0f)); a.inv[j] = 1.0f / pw; }
    for (int l = 0; l < 4; ++l) { const double li = 0.8 - 0.6 * std::exp(-0.3 * (double)l); a.lam_init[l] = (float)li; a.om_lam_init[l] = (float)(1.0 - li); }
#if MK_ONE_LAUNCH
    a.ph_lo = 0; a.ph_hi = N_PHASES;
    hipLaunchKernelGGL(fwd, dim3(grid), dim3(NWAVES * 64), LDS_BYTES, stream, a);
#else
    for (int ph = 0; ph < N_PHASES; ++ph) { a.ph_lo = ph; a.ph_hi = ph + 1; hipLaunchKernelGGL(fwd, dim3(grid), dim3(NWAVES * 64), LDS_BYTES, stream, a); }
#endif
    const hipError_t le = hipPeekAtLastError();
    if (le != hipSuccess) fprintf(stderr, "kernel_launch: launch failed: %s\n", hipGetErrorName(le));
}
```

```cpp
#include <hip/hip_runtime.h>
#include <cstdio>
#include <cstdint>
#include <cmath>

#ifndef MK_ONE_LAUNCH
#define MK_ONE_LAUNCH 1
#endif

constexpr int L = 8192, DM = 2048, NLAYER = 4, INC = 16384, DFF = 8192, HD = 128, NH = 8, DV2 = 256, CH = 128, NCH = L / CH;
constexpr float NORM_EPS = 1e-6f, GN_EPS = 1e-5f;
constexpr int NWAVES = 8;
namespace pg8 {
#define PG8_LAS __attribute__((address_space(3)))
typedef unsigned short bf16_t;
typedef short bf16x8 __attribute__((ext_vector_type(8)));
typedef float f32x4 __attribute__((ext_vector_type(4)));
typedef unsigned u32x4 __attribute__((ext_vector_type(4)));
constexpr int BM = 256, BK = 64, HALF = 128, HTB = HALF * BK * 2  , STAGE_BYTES = 8 * HTB, NXCD = 8, WGM = 4;

__host__ __device__ __forceinline__ int lds_byte(int r, int c) { const int st = (r >> 4) * 2 + (c >> 5), rr = r & 15, cc = c & 31, ob = rr * 64 + cc * 2; return st * 1024 + (ob ^ (((ob >> 9) & 1) << 5)); }
__host__ __device__ __forceinline__ void stage_rc(int b, int& R, int& C) { const int st = b / 1024, sb = b % 1024, swz = sb ^ (((sb >> 9) & 1) << 5); R = (st >> 1) * 16 + swz / 64; C = (st & 1) * 32 + (swz % 64) / 2; }
__host__ __device__ __forceinline__ int perm32(int rho) { const int n = rho >> 4, i = rho & 15; return 8 * (i >> 2) + 4 * n + (i & 3); }

struct Unit { int pm, pn; };
struct Gemm { const bf16_t* A; const bf16_t* Bt; int M, N, K; };

struct StaticOrder {
    int nM, nN, nwg, G, c;
    __host__ __device__ void init(int M, int N, int G_, int c_) { nM = M / BM; nN = N / BM; nwg = nM * nN; G = G_; c = c_; }
    __host__ __device__ bool next(int i, Unit& u) const {
        const long L = (long)i * G + c; if (L >= nwg) return false;
        int wgid = (int)L; { const int q = nwg / NXCD, r = nwg % NXCD, xcd = wgid % NXCD, off = wgid / NXCD; wgid = (xcd < r ? xcd * (q + 1) : r * (q + 1) + (xcd - r) * q) + off; }
        const int nig = WGM * nN, gid = wgid / nig, fm = gid * WGM, gsz = (nM - fm) < WGM ? (nM - fm) : WGM;
        u.pm = fm + ((wgid % nig) % gsz); u.pn = (wgid % nig) / gsz; return true;
    }
    __device__ __forceinline__ void a_ready(const Unit&) const {}
    __device__ __forceinline__ void done(const Unit&) const {}
};
template <class Epi, class Sched, bool ALIGN_EPI = false, bool SP2 = false>
__device__ __forceinline__ void gemm_phase(PG8_LAS unsigned char* lds, const Gemm g, const Sched& S, const Epi& E, const int wid_in  ) {
    int lane_; asm volatile("v_mbcnt_lo_u32_b32 %0, -1, 0\n\tv_mbcnt_hi_u32_b32 %0, -1, %0" : "=v"(lane_)); int wid_ = wid_in; asm volatile("" : "+s"(wid_)); const int wid = wid_ & 7, tid = wid * 64 + (lane_ & 63), lane = tid & 63, wr = wid >> 2, wc = wid & 3, fr = lane & 15, fq = lane >> 4;
    const int K = g.K, nt = K / BK;
    unsigned voffA[2], voffB[2];
#pragma unroll
    for (int i = 0; i < 2; ++i) { int R, C; stage_rc(tid * 16 + i * 8192, R, C); const int Rb = Epi::PERM ? ((R & ~31) + perm32(R & 31)) : R;
        voffA[i] = (unsigned)(R * K + C) * 2u; voffB[i] = (unsigned)(Rb * K + C) * 2u; }
    const size_t kstep = (size_t)(BK * 2);
    const size_t hstep = (size_t)HALF * K * 2;
    const size_t tstep = 2 * hstep;
    const unsigned ldsw = (unsigned)wid * 1024u;
    const int aoff = lds_byte(wr * 64 + fr, fq * 8), boff = lds_byte(wc * 32 + fr, fq * 8);
#define PG8_SA(b, h) (((b) * 2 + (h)) * HTB)
#define PG8_SB(b, h) ((4 + (b) * 2 + (h)) * HTB)
#define PG8_STAGE(bufoff, gbase, voff) do { _Pragma("unroll") for (int _i = 0; _i < 2; ++_i) \
        __builtin_amdgcn_global_load_lds((const unsigned*)((const char*)(gbase) + (voff)[_i]), (PG8_LAS unsigned*)(lds + (bufoff) + ldsw + _i * 8192), 16, 0, 0); } while (0)
#define PG8_LDA(dst, b, h) do { _Pragma("unroll") for (int m = 0; m < 4; ++m) _Pragma("unroll") for (int k = 0; k < 2; ++k) dst[m][k] = *(const PG8_LAS bf16x8*)(lds + PG8_SA(b, h) + aoff + m * 2048 + k * 1024); } while (0)
#define PG8_LDB(dst, b, h) do { _Pragma("unroll") for (int n = 0; n < 2; ++n) _Pragma("unroll") for (int k = 0; k < 2; ++k) dst[n][k] = *(const PG8_LAS bf16x8*)(lds + PG8_SB(b, h) + boff + n * 2048 + k * 1024); } while (0)
#define PG8_MMA(ai, bj, At, Bt) do { __builtin_amdgcn_s_setprio(1); _Pragma("unroll") for (int m = 0; m < 4; ++m) _Pragma("unroll") for (int n = 0; n < 2; ++n) _Pragma("unroll") for (int k = 0; k < 2; ++k) \
        acc[ai][bj][m][n] = __builtin_amdgcn_mfma_f32_16x16x32_bf16(Bt[n][k], At[m][k], acc[ai][bj][m][n], 0, 0, 0); __builtin_amdgcn_s_setprio(0); } while (0)
#define PG8_WAIT_V(n) asm volatile("s_waitcnt vmcnt(" #n ")" ::: "memory")
#define PG8_WAIT_L(n) asm volatile("s_waitcnt lgkmcnt(" #n ")" ::: "memory")
#define PG8_BAR __builtin_amdgcn_s_barrier()
#define PG8_SCHED __builtin_amdgcn_sched_barrier(0)
    Unit cur, nxt; int ui = 0;
    if (!S.next(0, cur)) return;
    f32x4 acc[2][2][4][2];
#pragma unroll
    for (int a = 0; a < 2; ++a)
#pragma unroll
        for (int b = 0; b < 2; ++b)
#pragma unroll
            for (int m = 0; m < 4; ++m)
#pragma unroll
                for (int n = 0; n < 2; ++n) acc[a][b][m][n] = (f32x4){0.f, 0.f, 0.f, 0.f};
    bf16x8 At[4][2], B0[2][2], B1[2][2];
    const char* cA = (const char*)g.A + (size_t)cur.pm * tstep; const char* cB = (const char*)g.Bt + (size_t)cur.pn * tstep;
    S.a_ready(cur);
    if constexpr (SP2) {
        PG8_STAGE(PG8_SB(0, 0), cB, voffB); PG8_STAGE(PG8_SB(0, 1), cB + hstep, voffB); PG8_STAGE(PG8_SA(0, 0), cA, voffA); PG8_STAGE(PG8_SA(0, 1), cA + hstep, voffA);
        if (wr == 1) PG8_BAR;
        PG8_WAIT_V(2); PG8_BAR;
        PG8_STAGE(PG8_SB(1, 0), cB + kstep, voffB); PG8_STAGE(PG8_SA(1, 0), cA + kstep, voffA); PG8_STAGE(PG8_SB(1, 1), cB + hstep + kstep, voffB);
        PG8_WAIT_V(6); PG8_BAR;
    } else {
        PG8_STAGE(PG8_SB(0, 0), cB, voffB); PG8_STAGE(PG8_SA(0, 0), cA, voffA); PG8_STAGE(PG8_SB(0, 1), cB + hstep, voffB); PG8_STAGE(PG8_SA(0, 1), cA + hstep, voffA);
        if (wr == 1) PG8_BAR;
        PG8_WAIT_V(4); PG8_BAR;
        PG8_STAGE(PG8_SB(1, 0), cB + kstep, voffB); PG8_STAGE(PG8_SA(1, 0), cA + kstep, voffA); PG8_STAGE(PG8_SB(1, 1), cB + hstep + kstep, voffB);
        PG8_WAIT_V(6); PG8_BAR;
    }
    for (;;) {
        const bool has_next = S.next(ui + 1, nxt);
        const char* nA = has_next ? (const char*)g.A + (size_t)nxt.pm * tstep : cA; const char* nB = has_next ? (const char*)g.Bt + (size_t)nxt.pn * tstep : cB;
        for (int t = 0; t < nt; t += 2) {
            const bool last = (t == nt - 2);
            const char* a1 = cA + (size_t)(t + 1) * kstep;
            const char* a2 = last ? nA : cA + (size_t)(t + 2) * kstep; const char* b2 = last ? nB : cB + (size_t)(t + 2) * kstep;
            const char* a3 = a2 + kstep; const char* b3 = b2 + kstep;
            if (last && has_next) S.a_ready(nxt);
            if constexpr (SP2) {
            PG8_LDB(B0, 0, 0); PG8_LDB(B1, 0, 1); PG8_SCHED; PG8_LDA(At, 0, 0); PG8_STAGE(PG8_SA(1, 1), a1 + hstep, voffA);
            PG8_WAIT_V(8); PG8_WAIT_L(0); PG8_BAR; PG8_MMA(0, 0, At, B0); PG8_MMA(0, 1, At, B1); PG8_BAR; PG8_SCHED;
            PG8_LDA(At, 0, 1); PG8_STAGE(PG8_SB(0, 0), b2, voffB); PG8_STAGE(PG8_SB(0, 1), b2 + hstep, voffB); PG8_STAGE(PG8_SA(0, 0), a2, voffA);
            PG8_WAIT_V(8); PG8_WAIT_L(0); PG8_BAR; PG8_MMA(1, 0, At, B0); PG8_MMA(1, 1, At, B1); PG8_BAR; PG8_SCHED;
            PG8_LDB(B0, 1, 0); PG8_LDB(B1, 1, 1); PG8_SCHED; PG8_LDA(At, 1, 0); PG8_STAGE(PG8_SA(0, 1), a2 + hstep, voffA);
            PG8_WAIT_V(8); PG8_WAIT_L(0); PG8_BAR; PG8_MMA(0, 0, At, B0); PG8_MMA(0, 1, At, B1); PG8_BAR; PG8_SCHED;
            PG8_LDA(At, 1, 1); PG8_STAGE(PG8_SB(1, 0), b3, voffB); PG8_STAGE(PG8_SB(1, 1), b3 + hstep, voffB); PG8_STAGE(PG8_SA(1, 0), a3, voffA);
            PG8_WAIT_V(8); PG8_WAIT_L(0); PG8_BAR; PG8_MMA(1, 0, At, B0); PG8_MMA(1, 1, At, B1); PG8_BAR; PG8_SCHED;
            } else {
            PG8_LDB(B0, 0, 0); PG8_SCHED; PG8_LDA(At, 0, 0); PG8_STAGE(PG8_SA(1, 1), a1 + hstep, voffA);
            PG8_WAIT_L(8); PG8_BAR; PG8_WAIT_L(0); PG8_MMA(0, 0, At, B0); PG8_BAR; PG8_SCHED;
            PG8_LDB(B1, 0, 1); PG8_STAGE(PG8_SB(0, 0), b2, voffB);
            PG8_BAR; PG8_WAIT_L(0); PG8_MMA(0, 1, At, B1); PG8_BAR;
            PG8_LDA(At, 0, 1); PG8_STAGE(PG8_SA(0, 0), a2, voffA);
            PG8_BAR; PG8_WAIT_L(0); PG8_MMA(1, 0, At, B0); PG8_BAR; PG8_SCHED;
            PG8_STAGE(PG8_SB(0, 1), b2 + hstep, voffB);
            PG8_WAIT_V(6); PG8_BAR; PG8_MMA(1, 1, At, B1); PG8_BAR;
            PG8_LDB(B0, 1, 0); PG8_SCHED; PG8_LDA(At, 1, 0); PG8_STAGE(PG8_SA(0, 1), a2 + hstep, voffA);
            PG8_WAIT_L(8); PG8_BAR; PG8_WAIT_L(0); PG8_MMA(0, 0, At, B0); PG8_BAR; PG8_SCHED;
            PG8_LDB(B1, 1, 1); PG8_STAGE(PG8_SB(1, 0), b3, voffB);
            PG8_BAR; PG8_WAIT_L(0); PG8_MMA(0, 1, At, B1); PG8_BAR;
            PG8_LDA(At, 1, 1); PG8_STAGE(PG8_SA(1, 0), a3, voffA);
            PG8_BAR; PG8_WAIT_L(0); PG8_MMA(1, 0, At, B0); PG8_BAR; PG8_SCHED;
            PG8_STAGE(PG8_SB(1, 1), b3 + hstep, voffB);
            PG8_WAIT_V(6); PG8_BAR; PG8_MMA(1, 1, At, B1); PG8_BAR;
            }
        }
        if constexpr (ALIGN_EPI) { if (wr == 0) PG8_BAR; }
        if constexpr (!Epi::AFTER_DRAIN) { E(acc, cur, wr, wc, fr, fq); S.done(cur); }
        if (!has_next) break;
#pragma unroll
        for (int a = 0; a < 2; ++a)
#pragma unroll
            for (int b = 0; b < 2; ++b)
#pragma unroll
                for (int m = 0; m < 4; ++m)
#pragma unroll
                    for (int n = 0; n < 2; ++n) acc[a][b][m][n] = (f32x4){0.f, 0.f, 0.f, 0.f};
        cur = nxt; cA = nA; cB = nB; ++ui;
        if constexpr (ALIGN_EPI) { if (wr == 1) PG8_BAR; }
    }
    PG8_WAIT_V(0);
    if constexpr (!ALIGN_EPI) { if (wr == 0) PG8_BAR; }
    PG8_BAR;
    if constexpr (Epi::AFTER_DRAIN) { E.fused(acc, cur, wr, wc, fr, fq, lds, wid, lane); S.done(cur); }
#undef PG8_SA
#undef PG8_SB
#undef PG8_STAGE
#undef PG8_LDA
#undef PG8_LDB
#undef PG8_MMA
#undef PG8_WAIT_V
#undef PG8_WAIT_L
#undef PG8_BAR
#undef PG8_SCHED
}
}

constexpr size_t MiB = 1u << 20;
constexpr size_t WS_CTL = 0, CTL_ZERO_BYTES = 1 * MiB;
constexpr size_t WS_CONST = 2 * MiB;
constexpr size_t WS_ROPE = 4 * MiB;
constexpr size_t WS_W = 16 * MiB, W_LAYER = 152 * MiB;
constexpr size_t W_IN = 0, W_RO = 64 * MiB, W_DO = 72 * MiB, W_OUT = 80 * MiB, W_1 = 88 * MiB, W_2 = 120 * MiB;
constexpr size_t WS_XB = 640 * MiB, WS_QR = 672 * MiB, WS_KR = 688 * MiB, WS_VR = 704 * MiB, WS_GR = 736 * MiB, WS_DQ = 768 * MiB, WS_DK = 800 * MiB,
                 WS_DV = 832 * MiB, WS_SGR = 864 * MiB, WS_SGD = 896 * MiB, WS_KVF = 928 * MiB, WS_KVB = 992 * MiB, WS_STF = 1056 * MiB, WS_STB = 1088 * MiB,
                 WS_URET = 1120 * MiB, WS_ODIFF = 1152 * MiB, WS_T1 = 1184 * MiB, WS_MERGED = 1248 * MiB, WS_UMLP = 1280 * MiB, WS_ATT = 1408 * MiB, WS_SSQP = 1472 * MiB, WS_END = 1488 * MiB;
constexpr int CW_TMO = 0, CW_BAR = 4096;

constexpr int LDS_BYTES = 155648;
constexpr int MISC_OFF = 153600;

#define GAS __attribute__((address_space(1)))
#define LAS __attribute__((address_space(3)))
typedef unsigned short bf16_t;
typedef unsigned v4u __attribute__((ext_vector_type(4)));
typedef unsigned v2u __attribute__((ext_vector_type(2)));
typedef float f32x4 __attribute__((ext_vector_type(4)));
typedef float f32x16 __attribute__((ext_vector_type(16)));
typedef short bf16x8 __attribute__((ext_vector_type(8)));
typedef short s16x4 __attribute__((ext_vector_type(4)));
typedef GAS unsigned gu32;
#define RLX_AGENT __ATOMIC_RELAXED, __HIP_MEMORY_SCOPE_AGENT
#define LDS_WAIT() asm volatile("s_waitcnt lgkmcnt(0)" ::: "memory")
#define VM_WAIT() asm volatile("s_waitcnt vmcnt(0)" ::: "memory")
#define SBAR() __builtin_amdgcn_sched_barrier(0)
__device__ __forceinline__ unsigned f2bf(float f) { unsigned u = __builtin_bit_cast(unsigned, f); return (u + 0x7fffu + ((u >> 16) & 1u)) >> 16; }
__device__ __forceinline__ unsigned pk2(float lo, float hi) { return f2bf(lo) | (f2bf(hi) << 16); }
__device__ __forceinline__ float bf2f(unsigned short b) { return __builtin_bit_cast(float, (unsigned)b << 16); }
__device__ __forceinline__ float bflo(unsigned w) { return __builtin_bit_cast(float, w << 16); }
__device__ __forceinline__ float bfhi(unsigned w) { return __builtin_bit_cast(float, w & 0xffff0000u); }
__device__ __forceinline__ unsigned cvtpk(float lo, float hi) { unsigned r; asm volatile("v_cvt_pk_bf16_f32 %0, %1, %2" : "=v"(r) : "v"(lo), "v"(hi)); return r; }
__device__ __forceinline__ int crow(int r, int hi) { return (r & 3) + 8 * (r >> 2) + 4 * hi; }
__device__ __forceinline__ int lane_id() { int l; asm volatile("v_mbcnt_lo_u32_b32 %0, -1, 0\n\tv_mbcnt_hi_u32_b32 %0, -1, %0" : "=v"(l)); return l; }
template <int M> __device__ __forceinline__ float sw_xor(float v) { return __builtin_bit_cast(float, __builtin_amdgcn_ds_swizzle(__builtin_bit_cast(int, v), (M << 10) | 0x1f)); }
__device__ __forceinline__ void swap32(float& a, float& b) { asm volatile("s_nop 1\n\tv_permlane32_swap_b32 %0, %1\n\ts_nop 1" : "+v"(a), "+v"(b)); }
__device__ __forceinline__ float add_xor32(float v) { float a = v, b = v; swap32(a, b); return a + b; }
__device__ __forceinline__ float max_xor32(float v) { float a = v, b = v; swap32(a, b); return fmaxf(a, b); }
__device__ __forceinline__ float sum16(float v) { v += sw_xor<1>(v); v += sw_xor<2>(v); v += sw_xor<4>(v); v += sw_xor<8>(v); return v; }
__device__ __forceinline__ float sum32(float v) { v = sum16(v); v += sw_xor<16>(v); return v; }
__device__ __forceinline__ int opaque(int x) { asm volatile("" : "+v"(x)); return x & 511; }
__device__ __forceinline__ float wave_sum(float v) { return add_xor32(sum32(v)); }
__device__ __forceinline__ float wave_max(float v) { v = fmaxf(v, sw_xor<1>(v)); v = fmaxf(v, sw_xor<2>(v)); v = fmaxf(v, sw_xor<4>(v)); v = fmaxf(v, sw_xor<8>(v)); v = fmaxf(v, sw_xor<16>(v)); return max_xor32(v); }
__device__ __forceinline__ float fsigmoid(float x) { return __builtin_amdgcn_rcpf(1.f + __expf(-x)); }

#define XB_TMO      128
#define XB_XCNT(j)  (256  + 64 * (j))
#define XB_XSUB(j)  (1280 + 64 * (j))
#define XB_XGEN(j)  (2304 + 64 * (j))
#define XB_TOP      3328
#define XB_TOPGEN   3392
#define XCD_BAR_WORDS 3456
#define XB_SPIN_CAP (1u << 18)
__device__ __forceinline__ unsigned xb_ld(unsigned* p)              { return __hip_atomic_load(p, __ATOMIC_RELAXED, __HIP_MEMORY_SCOPE_AGENT); }
__device__ __forceinline__ unsigned xb_add(unsigned* p, unsigned v) { return __hip_atomic_fetch_add(p, v, __ATOMIC_RELAXED, __HIP_MEMORY_SCOPE_AGENT); }
__device__ __forceinline__ unsigned xb_xcc_id() { return (unsigned)__builtin_amdgcn_s_getreg((3 << 11) | 20) & 0xFu; }
#define XB_SPIN(cond, bar) do { unsigned _sp = 0; while (cond) { __builtin_amdgcn_s_sleep(1); \
    if ((++_sp & 255u) == 0u) { if (xb_ld(&(bar)[XB_TMO])) break; if (_sp > XB_SPIN_CAP) { atomicAdd(&(bar)[XB_TMO], 1u); break; } } } } while (0)
struct XcdBarrier { unsigned* bar; unsigned x; volatile LAS unsigned* st; };
__device__ __forceinline__ XcdBarrier xcd_barrier_post(unsigned* bar, volatile LAS unsigned* st, bool leader) {
    XcdBarrier b; b.bar = bar; b.x = xb_xcc_id(); b.st = st;
    if (leader) (void)xb_add(&bar[XB_XCNT(b.x)], 1u);
    return b;
}
__device__ __forceinline__ void xcd_barrier_complete(unsigned* bar, unsigned x, unsigned& nloc, unsigned& nx) {
    const unsigned G = gridDim.x * gridDim.y * gridDim.z;
    unsigned sum, cnt, mine, sp = 0u;
    for (;;) {
        sum = 0u; cnt = 0u; mine = 0u;
#pragma unroll
        for (unsigned j = 0; j < 16; ++j) { const unsigned c = xb_ld(&bar[XB_XCNT(j)]); sum += c; cnt += (c > 0u) ? 1u : 0u; mine = (j == x) ? c : mine; }
        if (sum == G) break;
        __builtin_amdgcn_s_sleep(1);
        if ((++sp & 255u) == 0u) { if (xb_ld(&bar[XB_TMO])) break; if (sp > XB_SPIN_CAP) { atomicAdd(&bar[XB_TMO], 1u); break; } }
    }
    nloc = mine > 0u ? mine : 1u; nx = cnt > 0u ? cnt : 1u;
}
__device__ __forceinline__ void xcd_barrier(const XcdBarrier& b, bool leader  ) {
    asm volatile("s_waitcnt vmcnt(0)" ::: "memory");
    __syncthreads();
    if (leader) {
        unsigned* bar = b.bar;
        __builtin_amdgcn_s_waitcnt(0);
        unsigned nloc = b.st[0], nx = b.st[1];
        if (nloc == 0u) { xcd_barrier_complete(bar, b.x, nloc, nx); b.st[0] = nloc; b.st[1] = nx; }
        const unsigned old = xb_add(&bar[XB_XSUB(b.x)], 1u);
        const unsigned gen = old / nloc;
        if (old + 1u == (gen + 1u) * nloc) {
            __builtin_amdgcn_fence(__ATOMIC_RELEASE, "agent");
            asm volatile("s_waitcnt vmcnt(0)" ::: "memory");
            const unsigned og = xb_add(&bar[XB_TOP], 1u);
            const unsigned tg = og / nx;
            if (og + 1u == (tg + 1u) * nx) xb_add(&bar[XB_TOPGEN], 1u);
            else XB_SPIN(xb_ld(&bar[XB_TOPGEN]) == tg, bar);
            __builtin_amdgcn_fence(__ATOMIC_ACQUIRE, "agent");
            xb_add(&bar[XB_XGEN(b.x)], 1u);
            asm volatile("s_waitcnt vmcnt(0)" ::: "memory");
        } else {
            XB_SPIN(xb_ld(&bar[XB_XGEN(b.x)]) == gen, bar);
            __builtin_amdgcn_fence(__ATOMIC_ACQUIRE, "agent");
            asm volatile("s_waitcnt vmcnt(0)" ::: "memory");
        }
    }
    __syncthreads();
}

struct Args {
    const float* in[16]; float* out; unsigned char* ws;
    float inv[64];
    float om_lam_init[4];
    float lam_init[4];
    int ph_lo, ph_hi, pad0, pad1;
};
struct Frame {
    LAS unsigned char* lds;
    unsigned char* ws;
    int tid, lane, wave, G;
};
#define WSP(T, off) ((T*)(F.ws + (off)))

using pg8::Unit;
__device__ __forceinline__ void rows_rs(const float* ssqp, int row0, int fq, float (&rs)[2][4]) {
    f32x4 pa[2][4], pb[2][4];
#pragma unroll
    for (int ai = 0; ai < 2; ++ai)
#pragma unroll
        for (int m = 0; m < 4; ++m) { const f32x4* p = (const f32x4*)(ssqp + (size_t)(row0 + ai * 128 + m * 16) * 32) + 2 * fq; pa[ai][m] = p[0]; pb[ai][m] = p[1]; }
#pragma unroll
    for (int ai = 0; ai < 2; ++ai)
#pragma unroll
        for (int m = 0; m < 4; ++m) { const f32x4 q = pa[ai][m] + pb[ai][m]; float t = (q[0] + q[1]) + (q[2] + q[3]); t += sw_xor<16>(t); t = add_xor32(t);
            rs[ai][m] = __builtin_amdgcn_rsqf(t * (1.0f / DM) + NORM_EPS); }
}
constexpr int RS_OFF = 139264;
__device__ __forceinline__ void rs_panel_to_lds(LAS unsigned char* lds, const float* ssqp, int pm, int tid) {
    if (tid < 256) { const f32x4* p = (const f32x4*)(ssqp + (size_t)(pm * 256 + tid) * 32); f32x4 q = p[0];
#pragma unroll
        for (int i = 1; i < 8; ++i) q += p[i];
        ((LAS float*)(lds + RS_OFF))[tid] = __builtin_amdgcn_rsqf(((q[0] + q[1]) + (q[2] + q[3])) * (1.0f / DM) + NORM_EPS); }
    __syncthreads();
}
__device__ __forceinline__ void rows_rs_c(LAS float* rsl, int prow, float (&rs)[2][4]) {
#pragma unroll
    for (int ai = 0; ai < 2; ++ai)
#pragma unroll
        for (int m = 0; m < 4; ++m) rs[ai][m] = rsl[prow + ai * 128 + m * 16];
}
struct EpiInProj {
    static constexpr bool PERM = true, AFTER_DRAIN = false;
    const float* ssqp; const float* cs; unsigned char* ws; LAS float* xch; const float* qw; const float* kw; LAS float* rsl; int pm_c;
    __device__ __forceinline__ void operator()(const f32x4 (&acc)[2][2][4][2], const Unit& u, int wr, int wc, int fr_, int fq_) const {
        (void)fr_; (void)fq_; const int ln_ = lane_id() & 63, fr = ln_ & 15, fq = ln_ >> 4;
        const int pn = u.pn, seg = pn >> 2, id = seg < 2 ? seg : (seg >> 1) + 1;
        const size_t boff = WS_QR + (size_t)(id < 2 ? 16 * id : 32 * (id - 1)) * MiB;
        const int ld = id < 2 ? 1024 : 2048, cb = (pn - (id < 2 ? 4 * id : 8 * (id - 1))) * 256;
        const int op = id < 2 ? 1 : (id == 3 ? 2 : (id >= 7 ? 3 : ((id == 4 || id == 5) ? 4 : 0)));
        const float sc = id == 1 ? 0.08838834764831845f : 1.0f;
        bf16_t* base = (bf16_t*)(ws + boff);
        const int row0 = u.pm * 256 + wr * 64 + fr, col0 = cb + wc * 32 + 8 * fq, j0 = 16 * wc + 4 * fq;
        float rs[2][4]; rows_rs_c(rsl, wr * 64 + fr, rs);
        if (op == 1) {
#pragma unroll
            for (int ai = 0; ai < 2; ++ai) {
                f32x4 ca[4], cb4[4];
#pragma unroll
                for (int m = 0; m < 4; ++m) { const GAS f32x4* cp = (const GAS f32x4*)(cs + ((size_t)(row0 + ai * 128 + m * 16) * 64 + j0) * 2); ca[m] = cp[0]; cb4[m] = cp[1]; }
#pragma unroll
                for (int m = 0; m < 4; ++m) {
                    bf16_t* rowp = base + (size_t)(row0 + ai * 128 + m * 16) * ld + col0; const f32x4 c0 = ca[m], c1 = cb4[m]; const float r = rs[ai][m] * sc;
#pragma unroll
                    for (int bj = 0; bj < 2; ++bj) {
                        const f32x4 v0 = acc[ai][bj][m][0] * r, v1 = acc[ai][bj][m][1] * r;
                        v4u w; w.x = cvtpk(v0[0] * c0[0] - v0[1] * c0[1], v0[1] * c0[0] + v0[0] * c0[1]); w.y = cvtpk(v0[2] * c0[2] - v0[3] * c0[3], v0[3] * c0[2] + v0[2] * c0[3]);
                        w.z = cvtpk(v1[0] * c1[0] - v1[1] * c1[1], v1[1] * c1[0] + v1[0] * c1[1]); w.w = cvtpk(v1[2] * c1[2] - v1[3] * c1[3], v1[3] * c1[2] + v1[2] * c1[3]);
                        *(GAS v4u*)(rowp + bj * 128) = w;
                    }
                }
                asm volatile("" ::: "memory");
            }
        } else if (op == 4) {
            LAS float* xp = xch + wr * 1024;
#pragma unroll
            for (int ai = 0; ai < 2; ++ai)
#pragma unroll
                for (int m = 0; m < 4; ++m)
#pragma unroll
                    for (int bj = 0; bj < 2; ++bj) { const f32x4 v0 = acc[ai][bj][m][0], v1 = acc[ai][bj][m][1];
                        float ss = (v0[0] * v0[0] + v0[1] * v0[1]) + (v0[2] * v0[2] + v0[3] * v0[3]) + (v1[0] * v1[0] + v1[1] * v1[1]) + (v1[2] * v1[2] + v1[3] * v1[3]);
                        ss += sw_xor<16>(ss); ss = add_xor32(ss);
                        if (fq == 0) xp[((ai * 4 + m) * 16 + fr) * 8 + bj * 4 + wc] = ss; }
            asm volatile("s_waitcnt lgkmcnt(0)" ::: "memory"); __builtin_amdgcn_s_barrier(); asm volatile("" ::: "memory");
            const float* gw = (id == 4) ? qw : kw;
            const f32x4 w1 = *(const GAS f32x4*)(gw + j0), w2 = *(const GAS f32x4*)(gw + 64 + j0);
#pragma unroll
            for (int ai = 0; ai < 2; ++ai) {
                f32x4 ca[4], cb4[4];
#pragma unroll
                for (int m = 0; m < 4; ++m) { const GAS f32x4* cp = (const GAS f32x4*)(cs + ((size_t)(row0 + ai * 128 + m * 16) * 64 + j0) * 2); ca[m] = cp[0]; cb4[m] = cp[1]; }
#pragma unroll
                for (int m = 0; m < 4; ++m) {
                    bf16_t* rowp = base + (size_t)(row0 + ai * 128 + m * 16) * ld + col0; const f32x4 c0 = ca[m], c1 = cb4[m]; const float r = rs[ai][m];
#pragma unroll
                    for (int bj = 0; bj < 2; ++bj) {
                        const f32x4 t = *(const LAS f32x4*)(xp + ((ai * 4 + m) * 16 + fr) * 8 + bj * 4);
                        const float cn = r * __builtin_amdgcn_rsqf(((t[0] + t[1]) + (t[2] + t[3])) * (r * r) * (1.0f / HD) + NORM_EPS);
                        const f32x4 v0 = acc[ai][bj][m][0] * cn, v1 = acc[ai][bj][m][1] * cn;
                        const float a0 = v0[0] * w1[0], b0 = v0[1] * w2[0], a1 = v0[2] * w1[1], b1 = v0[3] * w2[1], a2 = v1[0] * w1[2], b2 = v1[1] * w2[2], a3 = v1[2] * w1[3], b3 = v1[3] * w2[3];
                        v4u w; w.x = cvtpk(a0 * c0[0] - b0 * c0[1], b0 * c0[0] + a0 * c0[1]); w.y = cvtpk(a1 * c0[2] - b1 * c0[3], b1 * c0[2] + a1 * c0[3]);
                        w.z = cvtpk(a2 * c1[0] - b2 * c1[1], b2 * c1[0] + a2 * c1[1]); w.w = cvtpk(a3 * c1[2] - b3 * c1[3], b3 * c1[2] + a3 * c1[3]);
                        *(GAS v4u*)(rowp + bj * 128) = w;
                    }
                }
                asm volatile("" ::: "memory");
            }
        } else {
#pragma unroll
            for (int ai = 0; ai < 2; ++ai)
#pragma unroll
                for (int m = 0; m < 4; ++m) {
                    bf16_t* rowp = base + (size_t)(row0 + ai * 128 + m * 16) * ld + col0; const float r = rs[ai][m];
#pragma unroll
                    for (int bj = 0; bj < 2; ++bj) {
                        f32x4 v0 = acc[ai][bj][m][0] * r, v1 = acc[ai][bj][m][1] * r;
                        if (op == 2) {
#pragma unroll
                            for (int e = 0; e < 4; ++e) { v0[e] = v0[e] * fsigmoid(v0[e]); v1[e] = v1[e] * fsigmoid(v1[e]); }
                        } else if (op == 3) {
#pragma unroll
                            for (int e = 0; e < 4; ++e) { v0[e] = fsigmoid(v0[e]); v1[e] = fsigmoid(v1[e]); }
                        }
                        v4u w; w.x = cvtpk(v0[0], v0[1]); w.y = cvtpk(v0[2], v0[3]); w.z = cvtpk(v1[0], v1[1]); w.w = cvtpk(v1[2], v1[3]);
                        *(GAS v4u*)(rowp + bj * 128) = w;
                    }
                }
        }
    }
};
struct EpiGateA {
    static constexpr bool PERM = true, AFTER_DRAIN = false;
    const bf16_t* sg; bf16_t* T1;
    __device__ __forceinline__ void operator()(const f32x4 (&acc)[2][2][4][2], const Unit& u, int wr, int wc, int fr_, int fq_) const {
        (void)fr_; (void)fq_; const int ln_ = lane_id() & 63, fr = ln_ & 15, fq = ln_ >> 4;
        const int row0 = u.pm * 256 + wr * 64 + fr, col0 = u.pn * 256 + wc * 32 + 8 * fq;
        v4u g[2][4][2];
#pragma unroll
        for (int ai = 0; ai < 2; ++ai)
#pragma unroll
            for (int m = 0; m < 4; ++m)
#pragma unroll
                for (int bj = 0; bj < 2; ++bj) g[ai][m][bj] = *(const GAS v4u*)(sg + (size_t)(row0 + ai * 128 + m * 16) * DM + col0 + bj * 128);
#pragma unroll
        for (int ai = 0; ai < 2; ++ai)
#pragma unroll
            for (int m = 0; m < 4; ++m)
#pragma unroll
                for (int bj = 0; bj < 2; ++bj) {
                    const size_t off = (size_t)(row0 + ai * 128 + m * 16) * DM + col0 + bj * 128; const v4u q = g[ai][m][bj];
                    f32x4 v0 = acc[ai][bj][m][0], v1 = acc[ai][bj][m][1];
                    v0[0] *= bflo(q.x); v0[1] *= bfhi(q.x); v0[2] *= bflo(q.y); v0[3] *= bfhi(q.y);
                    v1[0] *= bflo(q.z); v1[1] *= bfhi(q.z); v1[2] *= bflo(q.w); v1[3] *= bfhi(q.w);
                    { v4u w; w.x = cvtpk(v0[0], v0[1]); w.y = cvtpk(v0[2], v0[3]); w.z = cvtpk(v1[0], v1[1]); w.w = cvtpk(v1[2], v1[3]); *(GAS v4u*)(T1 + off) = w; }
                }
    }
};
struct EpiGateB {
    static constexpr bool PERM = true, AFTER_DRAIN = false;
    const bf16_t* sg; const bf16_t* T1; bf16_t* out;
    __device__ __forceinline__ void operator()(const f32x4 (&acc)[2][2][4][2], const Unit& u, int wr, int wc, int fr_, int fq_) const {
        (void)fr_; (void)fq_; const int ln_ = lane_id() & 63, fr = ln_ & 15, fq = ln_ >> 4;
        const int row0 = u.pm * 256 + wr * 64 + fr, col0 = u.pn * 256 + wc * 32 + 8 * fq;
#pragma unroll
        for (int ai = 0; ai < 2; ++ai) {
            v4u g[4][2], tq[4][2];
#pragma unroll
            for (int m = 0; m < 4; ++m)
#pragma unroll
                for (int bj = 0; bj < 2; ++bj) { const size_t off = (size_t)(row0 + ai * 128 + m * 16) * DM + col0 + bj * 128;
                    g[m][bj] = *(const GAS v4u*)(sg + off); tq[m][bj] = *(const GAS v4u*)(T1 + off); }
#pragma unroll
            for (int m = 0; m < 4; ++m)
#pragma unroll
                for (int bj = 0; bj < 2; ++bj) { const size_t off = (size_t)(row0 + ai * 128 + m * 16) * DM + col0 + bj * 128; const v4u q = g[m][bj], tt = tq[m][bj]; const f32x4 a0 = {bflo(tt.x), bfhi(tt.x), bflo(tt.y), bfhi(tt.y)}, a1 = {bflo(tt.z), bfhi(tt.z), bflo(tt.w), bfhi(tt.w)};
                    f32x4 v0 = acc[ai][bj][m][0], v1 = acc[ai][bj][m][1];
                    v0[0] = a0[0] + v0[0] * bflo(q.x); v0[1] = a0[1] + v0[1] * bfhi(q.x); v0[2] = a0[2] + v0[2] * bflo(q.y); v0[3] = a0[3] + v0[3] * bfhi(q.y);
                    v1[0] = a1[0] + v1[0] * bflo(q.z); v1[1] = a1[1] + v1[1] * bfhi(q.z); v1[2] = a1[2] + v1[2] * bflo(q.w); v1[3] = a1[3] + v1[3] * bfhi(q.w);
                    v4u w; w.x = cvtpk(v0[0], v0[1]); w.y = cvtpk(v0[2], v0[3]); w.z = cvtpk(v1[0], v1[1]); w.w = cvtpk(v1[2], v1[3]);
                    *(GAS v4u*)(out + off) = w; }
            asm volatile("" ::: "memory");
        }
    }
};
struct EpiResid {
    static constexpr bool PERM = true, AFTER_DRAIN = false;
    float* xout; bf16_t* xb; float* ssqp_out;
    __device__ __forceinline__ void operator()(const f32x4 (&acc)[2][2][4][2], const Unit& u, int wr, int wc, int fr_, int fq_) const {
        (void)fr_; (void)fq_; const int ln_ = lane_id() & 63, fr = ln_ & 15, fq = ln_ >> 4;
        const int row0 = u.pm * 256 + wr * 64 + fr, col0 = u.pn * 256 + wc * 32 + 8 * fq;
#pragma unroll
        for (int ai = 0; ai < 2; ++ai) {
            v4u xq[4][2];
#pragma unroll
            for (int m = 0; m < 4; ++m)
#pragma unroll
                for (int bj = 0; bj < 2; ++bj) { const size_t off = (size_t)(row0 + ai * 128 + m * 16) * DM + col0 + bj * 128; xq[m][bj] = *(const GAS v4u*)(xb + off); }
#pragma unroll
            for (int m = 0; m < 4; ++m) {
                const int row = row0 + ai * 128 + m * 16; float ps = 0.f;
#pragma unroll
                for (int bj = 0; bj < 2; ++bj) {
                    const size_t off = (size_t)row * DM + col0 + bj * 128; const v4u q = xq[m][bj];
                    f32x4 v0 = acc[ai][bj][m][0], v1 = acc[ai][bj][m][1];
                    v0[0] += bflo(q.x); v0[1] += bfhi(q.x); v0[2] += bflo(q.y); v0[3] += bfhi(q.y); v1[0] += bflo(q.z); v1[1] += bfhi(q.z); v1[2] += bflo(q.w); v1[3] += bfhi(q.w);
                    if (xout) { *(GAS f32x4*)(xout + off) = v0; *(GAS f32x4*)(xout + off + 4) = v1; }
                    ps += (v0[0] * v0[0] + v0[1] * v0[1]) + (v0[2] * v0[2] + v0[3] * v0[3]) + (v1[0] * v1[0] + v1[1] * v1[1]) + (v1[2] * v1[2] + v1[3] * v1[3]);
                    v4u w; w.x = cvtpk(v0[0], v0[1]); w.y = cvtpk(v0[2], v0[3]); w.z = cvtpk(v1[0], v1[1]); w.w = cvtpk(v1[2], v1[3]);
                    *(GAS v4u*)(xb + off) = w;
                }
                ps += sw_xor<16>(ps); ps = add_xor32(ps);
                if (fq == 0) ((GAS float*)ssqp_out)[(size_t)row * 32 + u.pn * 4 + wc] = ps;
            }
            asm volatile("" ::: "memory");
        }
    }
};
struct EpiMlpIn {
    static constexpr bool PERM = true, AFTER_DRAIN = false;
    const float* ssqp; bf16_t* out; LAS float* rsl; int pm_c;
    __device__ __forceinline__ void operator()(const f32x4 (&acc)[2][2][4][2], const Unit& u, int wr, int wc, int fr_, int fq_) const {
        (void)fr_; (void)fq_; const int ln_ = lane_id() & 63, fr = ln_ & 15, fq = ln_ >> 4;
        const int row0 = u.pm * 256 + wr * 64 + fr, col0 = u.pn * 256 + wc * 32 + 8 * fq;
        float rs[2][4]; rows_rs_c(rsl, wr * 64 + fr, rs);
#pragma unroll
        for (int ai = 0; ai < 2; ++ai)
#pragma unroll
            for (int m = 0; m < 4; ++m) {
                const int row = row0 + ai * 128 + m * 16; const float r = rs[ai][m];
#pragma unroll
                for (int bj = 0; bj < 2; ++bj) {
                    f32x4 v0 = acc[ai][bj][m][0] * r, v1 = acc[ai][bj][m][1] * r;
#pragma unroll
                    for (int e = 0; e < 4; ++e) { const float a = fmaxf(v0[e], 0.f), b = fmaxf(v1[e], 0.f); v0[e] = a * a; v1[e] = b * b; }
                    v4u w; w.x = cvtpk(v0[0], v0[1]); w.y = cvtpk(v0[2], v0[3]); w.z = cvtpk(v1[0], v1[1]); w.w = cvtpk(v1[2], v1[3]);
                    *(GAS v4u*)(out + (size_t)row * DFF + col0 + bj * 128) = w;
                }
            }
    }
};

__device__ __forceinline__ void l2_touch_tile(Frame& F, const bf16_t* base, int pm, int pn) {
    const int t = F.wave * 64 + (lane_id() & 63);
    LAS unsigned* dummy = (LAS unsigned*)(F.lds + 143360 + F.wave * 256);
#pragma unroll
    for (int i = 0; i < 2; ++i) { const int ln = t + 512 * i, row = ln >> 2, seg = ln & 3;
        __builtin_amdgcn_global_load_lds((const unsigned*)((const char*)base + ((size_t)(pm * 256 + row) * DM + pn * 256) * 2 + seg * 128), dummy, 4, 0, 0); }
}
__device__ __forceinline__ float log2_gamma_calc(const float* logit) { const float x = *logit; return -log1pf(expf(-x)) * 1.4426950408889634f; }
__device__ __forceinline__ int srccol_win(int n) {
    const bool p = (n < 2048) || (n >= 6144 && n < 10240);
    return p ? ((n & ~127) + ((n & 127) >> 1) + ((n & 1) << 6)) : n;
}
constexpr int CP = 68;
struct ConvItem { const float* W; bf16_t* WT; const float* rscale; int K, N, rmask, k0, n0; float mulc; bool perm; };
__device__ __forceinline__ void conv_load(const ConvItem& d, f32x4 (&v)[16], int lane) {
    const int s4 = (lane & 15) * 4;
    const int col = d.perm ? ((d.n0 & ~127) + ((d.n0 & 127) >> 1) + (s4 & 31) + ((s4 >> 5) << 6)) : d.n0 + s4;
#pragma unroll
    for (int i = 0; i < 16; ++i) { const int kk = 4 * i + (lane >> 4); v[i] = __builtin_nontemporal_load((const f32x4*)(d.W + (size_t)(d.k0 + kk) * d.N + col)); }
}
__device__ __forceinline__ void conv_store(const ConvItem& d, const f32x4 (&v)[16], LAS float* scr, int lane) {
    const int s4 = (lane & 15) * 4;
#pragma unroll
    for (int i = 0; i < 16; ++i) { const int kk = 4 * i + (lane >> 4); const float sc = d.rscale ? d.rscale[(d.k0 + kk) & d.rmask] * d.mulc : 1.0f;
        *(LAS f32x4*)(scr + kk * CP + s4) = v[i] * sc; }
    LDS_WAIT(); asm volatile("" ::: "memory");
    const int c = lane & 7;
#pragma unroll
    for (int j = 0; j < 8; ++j) { const int r = (lane >> 3) + 8 * j, sidx = d.perm ? ((r >> 1) + 32 * (r & 1)) : r; const LAS float* q = scr + (8 * c) * CP + sidx;
        v4u o; o.x = pk2(q[0 * CP], q[1 * CP]); o.y = pk2(q[2 * CP], q[3 * CP]); o.z = pk2(q[4 * CP], q[5 * CP]); o.w = pk2(q[6 * CP], q[7 * CP]);
        *(v4u*)(d.WT + (size_t)(d.n0 + r) * d.K + d.k0 + 8 * c) = o; }
    LDS_WAIT(); asm volatile("" ::: "memory");
}
__device__ __forceinline__ void sincos_f32angle(float angf, float& c, float& s) {
    const double a = (double)angf;
    const double kq = __builtin_rint(a * 0.63661977236758134308);
    const double r = (a - kq * 1.5707963267948966192) - kq * 6.123233995736766e-17;
    const double r2 = r * r;
    double sp = -7.647163731819816e-13; sp = sp * r2 + 1.6059043836821613e-10; sp = sp * r2 - 2.5052108385441720e-08; sp = sp * r2 + 2.7557319223985893e-06;
    sp = sp * r2 - 1.9841269841269841e-04; sp = sp * r2 + 8.3333333333333333e-03; sp = sp * r2 - 1.6666666666666666e-01; const double sn = r + r * r2 * sp;
    double cp = 4.7794773323873853e-14; cp = cp * r2 - 1.1470745597729725e-11; cp = cp * r2 + 2.0876756987868099e-09; cp = cp * r2 - 2.7557319223985888e-07;
    cp = cp * r2 + 2.4801587301587302e-05; cp = cp * r2 - 1.3888888888888889e-03; cp = cp * r2 + 4.1666666666666664e-02; cp = cp * r2 - 0.5; const double cn = 1.0 + r2 * cp;
    const int q = ((int)kq) & 3;
    const double cc = (q == 0) ? cn : (q == 1) ? -sn : (q == 2) ? -cn : sn;
    const double ss = (q == 0) ? sn : (q == 1) ? cn : (q == 2) ? -sn : -cn;
    c = (float)cc; s = (float)ss;
}
#define CONV_DESC(d, it_) ConvItem d; { int r = (it_); \
    if (r < I_2) { d.W = w2s; d.K = DFF; d.N = DM; d.WT = (bf16_t*)(wl + W_2); d.rscale = nullptr; d.rmask = 0; d.mulc = 1.0f; d.perm = false; } \
    else if ((r -= I_2) < I_1) { d.W = w1s; d.K = DM; d.N = DFF; d.WT = (bf16_t*)(wl + W_1); d.rscale = g_mlp; d.rmask = DM - 1; d.mulc = 1.0f; d.perm = false; } \
    else if ((r -= I_1) < I_SQ) { d.W = wos; d.K = DM; d.N = DM; d.WT = (bf16_t*)(wl + W_OUT); d.rscale = nullptr; d.rmask = 0; d.mulc = 1.0f; d.perm = false; } \
    else if ((r -= I_SQ) < I_SQ) { d.W = wds; d.K = DM; d.N = DM; d.WT = (bf16_t*)(wl + W_DO); d.rscale = g_sub; d.rmask = DV2 - 1; d.mulc = oml; d.perm = false; } \
    else if ((r -= I_SQ) < I_SQ) { d.W = wrs; d.K = DM; d.N = DM; d.WT = (bf16_t*)(wl + W_RO); d.rscale = g_gn; d.rmask = DM - 1; d.mulc = 1.0f; d.perm = false; } \
    else { r -= I_SQ; d.W = wis; d.K = DM; d.N = INC; d.WT = (bf16_t*)(wl + W_IN); d.rscale = g_mix; d.rmask = DM - 1; d.mulc = 1.0f; d.perm = true; } \
    const int nblk = d.N / 64; d.k0 = 64 * (r / nblk); d.n0 = 64 * (r % nblk); \
    d.perm = d.perm && (d.n0 < 2048 || (d.n0 >= 6144 && d.n0 < 10240)); }
__device__ __forceinline__ void conv_layer(Frame& F, const Args& A, int l) {
    LAS float* scr = (LAS float*)(F.lds + F.wave * 17408);
    const int gw = blockIdx.x * NWAVES + F.wave, NGW = F.G * NWAVES, ln = lane_id() & 63;
    constexpr int I_IN = (DM / 64) * (INC / 64), I_SQ = (DM / 64) * (DM / 64), I_1 = (DM / 64) * (DFF / 64), I_2 = (DFF / 64) * (DM / 64);
    constexpr int I_LAYER = I_IN + 3 * I_SQ + I_1 + I_2;
    unsigned char* wl = F.ws + WS_W + (size_t)l * W_LAYER;
    const float* w2s = A.in[15] + (size_t)l * DFF * DM; const float* w1s = A.in[14] + (size_t)l * DM * DFF; const float* wos = A.in[12] + (size_t)l * DM * DM;
    const float* wds = A.in[11] + (size_t)l * DM * DM; const float* wrs = A.in[6] + (size_t)l * DM * DM; const float* wis = A.in[2] + (size_t)l * DM * INC;
    const float* g_mlp = A.in[13] + l * DM; const float* g_sub = A.in[10] + l * DV2; const float* g_gn = A.in[5] + l * DM; const float* g_mix = A.in[1] + l * DM; const float oml = A.om_lam_init[l];
    f32x4 va[16], vb[16]; int i0 = gw, i1 = gw + NGW;
    if (i0 < I_LAYER) { CONV_DESC(d, i0); conv_load(d, va, ln); }
    while (i0 < I_LAYER) {
        if (i1 < I_LAYER) { CONV_DESC(d, i1); conv_load(d, vb, ln); }
        { CONV_DESC(d, i0); conv_store(d, va, scr, ln); }
        i0 = i1 + NGW;
        if (i1 >= I_LAYER) break;
        if (i0 < I_LAYER) { CONV_DESC(d, i0); conv_load(d, va, ln); }
        { CONV_DESC(d, i1); conv_store(d, vb, scr, ln); }
        i1 = i0 + NGW;
    }
}
#undef CONV_DESC
__device__ __forceinline__ void p0_prologue(Frame& F, const Args& A) {
    const int gw = blockIdx.x * NWAVES + F.wave, NGW = F.G * NWAVES;
    conv_layer(F, A, 0);
    {
        const float* x = A.in[0]; bf16_t* xb = WSP(bf16_t, WS_XB); float* ssqp = WSP(float, WS_SSQP);
        for (int m = gw; m < L; m += NGW) {
            const f32x4* xr = (const f32x4*)(x + (size_t)m * DM) + F.lane; float s = 0.f;
            unsigned long long* o8 = (unsigned long long*)(xb + (size_t)m * DM) + F.lane;
#pragma unroll
            for (int j = 0; j < 8; ++j) { const f32x4 v = xr[64 * j]; s += (v[0] * v[0] + v[1] * v[1]) + (v[2] * v[2] + v[3] * v[3]);
                o8[64 * j] = (unsigned long long)pk2(v[0], v[1]) | ((unsigned long long)pk2(v[2], v[3]) << 32); }
            s = wave_sum(s);
            if (F.lane < 32) ssqp[(size_t)m * 32 + F.lane] = F.lane == 0 ? s : 0.f;
        }
    }
    {
        float* cs = WSP(float, WS_ROPE);
        for (int p = gw; p < L; p += NGW) { const float ang = (float)p * A.inv[F.lane]; float c, s; sincos_f32angle(ang, c, s);
            *(float2*)(cs + ((size_t)p * 64 + F.lane) * 2) = make_float2(c, s); }
    }
    if (blockIdx.x == 0 && F.wave < NLAYER) {
        const int l = F.wave; const float* lp = A.in[9] + l * 4 * HD; const float* qw = A.in[7] + l * HD; const float* kw = A.in[8] + l * HD;
        float s01 = 0.f, s23 = 0.f, mq = 0.f, mk = 0.f;
        for (int i = F.lane; i < HD; i += 64) { s01 += lp[i] * lp[HD + i]; s23 += lp[2 * HD + i] * lp[3 * HD + i]; mq = fmaxf(mq, fabsf(qw[i])); mk = fmaxf(mk, fabsf(kw[i])); }
        s01 = wave_sum(s01); s23 = wave_sum(s23);
        mq = wave_max(mq); mk = wave_max(mk);
        if (F.lane < 2 * NH) { const int dir = F.lane >> 3, h = F.lane & 7; WSP(float, WS_CONST)[8 + (l * 2 + dir) * NH + h] = log2_gamma_calc((dir ? A.in[4] : A.in[3]) + l * NH + h); }
        if (F.lane == 0) { float* cst = WSP(float, WS_CONST); cst[l] = expf(s01) - expf(s23) + A.lam_init[l];
            cst[4 + l] = 128.0f * mq * mk * 0.12751743082459868f; }
    }
}

constexpr int TP = 136;
#define LG2G(F, layer, dir, h) (WSP(float, WS_CONST)[8 + ((layer) * 2 + (dir)) * NH + (h)])
__device__ __forceinline__ void phase_r1(Frame& F, const Args& A, int layer) {
    LAS bf16_t* KtF = (LAS bf16_t*)F.lds; LAS bf16_t* KtB = KtF + 128 * TP; LAS bf16_t* Vt = KtB + 128 * TP;
    const int wid = F.wave;
    const bf16_t* KR = WSP(bf16_t, WS_KR); const bf16_t* VR = WSP(bf16_t, WS_VR);
    for (int u = blockIdx.x; u < NCH * NH; u += F.G) {
        const int cc = u >> 3, h = u & 7;
        const float lgf = LG2G(F, layer, 0, h), lgb = LG2G(F, layer, 1, h);
        const int tid_o = (F.wave * 64 + (lane_id() & 63)), r32 = tid_o & 31, hi = (tid_o >> 5) & 1;
        __syncthreads();
        v4u kq[4], vq[8];
#pragma unroll
        for (int i = 0; i < 4; ++i) { const int q = tid_o + 512 * i, pos = q & 127, d0 = (q >> 7) * 8; kq[i] = *(const GAS v4u*)(KR + (size_t)(cc * CH + pos) * 1024 + h * HD + d0); }
#pragma unroll
        for (int i = 0; i < 8; ++i) { const int q = tid_o + 512 * i, pos = q & 127, d0 = (q >> 7) * 8; vq[i] = *(const GAS v4u*)(VR + (size_t)(cc * CH + pos) * DM + h * DV2 + d0); }
#pragma unroll
        for (int i = 0; i < 4; ++i) { const int q = tid_o + 512 * i, pos = q & 127, d0 = (q >> 7) * 8;
            const v4u v = kq[i];
            const float wf = __builtin_amdgcn_exp2f((float)(127 - pos) * lgf), wb = __builtin_amdgcn_exp2f((float)pos * lgb);
            const float e[8] = {bflo(v.x), bfhi(v.x), bflo(v.y), bfhi(v.y), bflo(v.z), bfhi(v.z), bflo(v.w), bfhi(v.w)};
#pragma unroll
            for (int k = 0; k < 8; ++k) { KtF[(d0 + k) * TP + pos] = (bf16_t)f2bf(e[k] * wf); KtB[(d0 + k) * TP + pos] = (bf16_t)f2bf(e[k] * wb); } }
#pragma unroll
        for (int i = 0; i < 8; ++i) { const int q = tid_o + 512 * i, pos = q & 127, d0 = (q >> 7) * 8;
            const v4u v = vq[i];
            const unsigned w[4] = {v.x, v.y, v.z, v.w};
#pragma unroll
            for (int k = 0; k < 4; ++k) { Vt[(d0 + 2 * k) * TP + pos] = (bf16_t)(w[k] & 0xffffu); Vt[(d0 + 2 * k + 1) * TP + pos] = (bf16_t)(w[k] >> 16); } }
        __syncthreads();
#pragma unroll
        for (int dir = 0; dir < 2; ++dir) {
            const LAS bf16_t* Kt = dir ? KtB : KtF;
            f32x16 acc[4];
#pragma unroll
            for (int n = 0; n < 4; ++n)
#pragma unroll
                for (int r = 0; r < 16; ++r) acc[n][r] = 0.f;
#pragma unroll 2
            for (int ks = 0; ks < 8; ++ks) {
                const bf16x8 a = *(const LAS bf16x8*)(Vt + (32 * wid + r32) * TP + ks * 16 + hi * 8);
#pragma unroll
                for (int n = 0; n < 4; ++n) { const bf16x8 b = *(const LAS bf16x8*)(Kt + (32 * n + r32) * TP + ks * 16 + hi * 8);
                    acc[n] = __builtin_amdgcn_mfma_f32_32x32x16_bf16(a, b, acc[n], 0, 0, 0); }
            }
            bf16_t* out = (dir ? WSP(bf16_t, WS_KVB) : WSP(bf16_t, WS_KVF)) + ((size_t)(cc * NH + h) * DV2 + 32 * wid) * HD;
#pragma unroll
            for (int n = 0; n < 4; ++n)
#pragma unroll
                for (int r = 0; r < 16; ++r) ((GAS bf16_t*)out)[crow(r, hi) * HD + 32 * n + r32] = (bf16_t)f2bf(acc[n][r]);
        }
    }
}
__device__ __forceinline__ void phase_r2(Frame& F, const Args& A, int layer) {
    constexpr int PER_DIR = NH * DV2 * HD / 4;
    constexpr size_t CSTR = (size_t)NH * DV2 * HD;
    for (int gid = blockIdx.x * 512 + (F.wave * 64 + (lane_id() & 63)); gid < 2 * PER_DIR; gid += F.G * 512) {
        const int dir = gid >= PER_DIR, e4 = gid - dir * PER_DIR, h = e4 / (DV2 * HD / 4);
        const float lg = LG2G(F, layer, dir, h), Gm = __builtin_amdgcn_exp2f(128.0f * lg);
        const bf16_t* kv = (dir ? WSP(bf16_t, WS_KVB) : WSP(bf16_t, WS_KVF)) + (size_t)e4 * 4;
        bf16_t* st = (dir ? WSP(bf16_t, WS_STB) : WSP(bf16_t, WS_STF)) + (size_t)e4 * 4;
        f32x4 s = {0.f, 0.f, 0.f, 0.f};
#pragma unroll 8
        for (int i = 0; i < NCH; ++i) { const int c = dir ? (NCH - 1 - i) : i;
            const v2u vw = *(const v2u*)(kv + (size_t)c * CSTR); const f32x4 v = {bflo(vw.x), bfhi(vw.x), bflo(vw.y), bfhi(vw.y)};
            v2u o; o.x = cvtpk(s[0], s[1]); o.y = cvtpk(s[2], s[3]); *(v2u*)(st + (size_t)c * CSTR) = o;
            s = s * Gm + v; }
    }
}
__device__ __forceinline__ bf16x8 scale_bf8(bf16x8 q, float a) {
    v4u w = __builtin_bit_cast(v4u, q), o;
    o.x = cvtpk(bflo(w.x) * a, bfhi(w.x) * a); o.y = cvtpk(bflo(w.y) * a, bfhi(w.y) * a); o.z = cvtpk(bflo(w.z) * a, bfhi(w.z) * a); o.w = cvtpk(bflo(w.w) * a, bfhi(w.w) * a);
    return __builtin_bit_cast(bf16x8, o);
}
__device__ __forceinline__ void phase_r3(Frame& F, const Args& A, int layer) {
    LAS bf16_t* Ks = (LAS bf16_t*)F.lds; LAS bf16_t* Vt = Ks + 128 * TP;
    const int wid = F.wave;
    const bf16_t* QR = WSP(bf16_t, WS_QR); const bf16_t* KR = WSP(bf16_t, WS_KR); const bf16_t* VR = WSP(bf16_t, WS_VR); const bf16_t* GR = WSP(bf16_t, WS_GR);
    bf16_t* UR = WSP(bf16_t, WS_URET);
    for (int u = blockIdx.x; u < NCH * NH; u += F.G) {
        const int cc = u >> 3, h = u & 7;
        const int tid_o = (F.wave * 64 + (lane_id() & 63)), lane_o = tid_o & 63, c16 = lane_o & 15, g = lane_o >> 4;
        const float lgf = LG2G(F, layer, 0, h), lgb = LG2G(F, layer, 1, h);
        __syncthreads();
        v4u kq[4], vq[8];
#pragma unroll
        for (int i = 0; i < 4; ++i) { const int q = tid_o + 512 * i, row = q >> 4, ch = q & 15; kq[i] = *(const GAS v4u*)(KR + (size_t)(cc * CH + row) * 1024 + h * HD + ch * 8); }
#pragma unroll
        for (int i = 0; i < 8; ++i) { const int q = tid_o + 512 * i, pos = q & 127, d0 = (q >> 7) * 8; vq[i] = *(const GAS v4u*)(VR + (size_t)(cc * CH + pos) * DM + h * DV2 + d0); }
#pragma unroll
        for (int i = 0; i < 4; ++i) { const int q = tid_o + 512 * i, row = q >> 4, ch = q & 15; *(LAS v4u*)(Ks + row * TP + ch * 8) = kq[i]; }
#pragma unroll
        for (int i = 0; i < 8; ++i) { const int q = tid_o + 512 * i, pos = q & 127, d0 = (q >> 7) * 8;
            const v4u v = vq[i];
            const unsigned w[4] = {v.x, v.y, v.z, v.w};
#pragma unroll
            for (int k = 0; k < 4; ++k) { Vt[(d0 + 2 * k) * TP + pos] = (bf16_t)(w[k] & 0xffffu); Vt[(d0 + 2 * k + 1) * TP + pos] = (bf16_t)(w[k] >> 16); } }
        __syncthreads();
        const int pos_i = 16 * wid + c16; const size_t gpos = (size_t)cc * CH + pos_i;
        bf16x8 qf[4];
#pragma unroll
        for (int s = 0; s < 4; ++s) qf[s] = *(const GAS bf16x8*)(QR + gpos * 1024 + h * HD + 32 * s + 8 * g);
        f32x4 st[8];
#pragma unroll
        for (int b = 0; b < 8; ++b) { st[b] = (f32x4){0.f, 0.f, 0.f, 0.f};
#pragma unroll
            for (int s = 0; s < 4; ++s) { const bf16x8 a = *(const LAS bf16x8*)(Ks + (16 * b + c16) * TP + 32 * s + 8 * g);
                st[b] = __builtin_amdgcn_mfma_f32_16x16x32_bf16(a, qf[s], st[b], 0, 0, 0); } }
#pragma unroll
        for (int b = 0; b < 8; ++b)
#pragma unroll
            for (int r = 0; r < 4; ++r) { const int d = pos_i - (16 * b + 4 * g + r);
                const float m = d > 0 ? __builtin_amdgcn_exp2f((float)d * lgf) : (d < 0 ? __builtin_amdgcn_exp2f((float)(-d) * lgb) : 2.0f);
                st[b][r] *= m; }
        f32x4 R[16];
#pragma unroll
        for (int n = 0; n < 16; ++n) R[n] = (f32x4){0.f, 0.f, 0.f, 0.f};
#pragma unroll
        for (int s2 = 0; s2 < 4; ++s2) {
            v4u pw; pw.x = cvtpk(st[2 * s2][0], st[2 * s2][1]); pw.y = cvtpk(st[2 * s2][2], st[2 * s2][3]); pw.z = cvtpk(st[2 * s2 + 1][0], st[2 * s2 + 1][1]); pw.w = cvtpk(st[2 * s2 + 1][2], st[2 * s2 + 1][3]);
            const bf16x8 pa = __builtin_bit_cast(bf16x8, pw);
#pragma unroll
            for (int n = 0; n < 16; ++n) {
                const v2u lo = *(const LAS v2u*)(Vt + (16 * n + c16) * TP + 32 * s2 + 4 * g), hi4 = *(const LAS v2u*)(Vt + (16 * n + c16) * TP + 32 * s2 + 16 + 4 * g);
                v4u bw; bw.x = lo.x; bw.y = lo.y; bw.z = hi4.x; bw.w = hi4.y;
                R[n] = __builtin_amdgcn_mfma_f32_16x16x32_bf16(pa, __builtin_bit_cast(bf16x8, bw), R[n], 0, 0, 0);
            }
            asm volatile("" ::: "memory");
        }
#pragma unroll
        for (int dir = 0; dir < 2; ++dir) {
            const float asc = dir ? __builtin_amdgcn_exp2f((float)(CH - pos_i) * lgb) : __builtin_amdgcn_exp2f((float)(pos_i + 1) * lgf);
            const GAS bf16_t* ST = (const GAS bf16_t*)((dir ? WSP(bf16_t, WS_STB) : WSP(bf16_t, WS_STF)) + (size_t)(cc * NH + h) * DV2 * HD) + c16 * HD + 8 * g;
#pragma unroll
            for (int s = 0; s < 4; ++s) { const bf16x8 qs = scale_bf8(qf[s], asc); bf16x8 bq[16];
#pragma unroll
                for (int n = 0; n < 16; ++n) bq[n] = *(const GAS bf16x8*)(ST + n * (16 * HD) + 32 * s);
#pragma unroll
                for (int n = 0; n < 16; ++n) R[n] = __builtin_amdgcn_mfma_f32_16x16x32_bf16(qs, bq[n], R[n], 0, 0, 0);
                asm volatile("" ::: "memory"); }
        }
#pragma unroll
        for (int r = 0; r < 4; ++r) {
            float s = 0.f;
#pragma unroll
            for (int n = 0; n < 16; ++n) s += R[n][r];
            s = sum16(s);
            const float mean = s * (1.0f / DV2); float q = 0.f;
#pragma unroll
            for (int n = 0; n < 16; ++n) { const float d = R[n][r] - mean; q += d * d; }
            q = sum16(q);
            const float rstd = __builtin_amdgcn_rsqf(q * (1.0f / DV2) + GN_EPS);
            int c16o = c16; asm volatile("" : "+v"(c16o) : "v"(rstd));
            const size_t ro = ((size_t)cc * CH + 16 * wid + 4 * g + r) * DM + h * DV2 + (c16o & 15);
            const GAS bf16_t* gp = (const GAS bf16_t*)(GR + ro); GAS bf16_t* up = (GAS bf16_t*)(UR + ro);
#pragma unroll
            for (int n = 0; n < 16; ++n) up[16 * n] = (bf16_t)f2bf((R[n][r] - mean) * rstd * bf2f(gp[16 * n]));
            asm volatile("" ::: "memory");
        }
    }
}

constexpr int AK_BYTES = 16384, AV_BYTES = 32768, AV_OFF = 2 * AK_BYTES, ASCR_OFF = AV_OFF + 3 * AV_BYTES;
#define KSWZ(row, colB) ((row) * 256 + ((colB) ^ (((row) & 15) << 4)))
__device__ __forceinline__ int v_rd_base(int lane) { const int g = lane >> 4, qq = (lane >> 2) & 3, p = lane & 3, x = (2 * (g & 1) + (g >> 1)) & 3;
    return 4096 * (g & 1) + 64 * (4 * (g >> 1) + qq) + 16 * ((p >> 1) ^ x) + 8 * (p & 1); }
constexpr int v_rd_off(int e, int m, int hh) { return 16384 * m + 8192 * hh + 512 * e; }
template <int OFF> __device__ __forceinline__ s16x4 tr_read(int vb) {
    s16x4 r; asm volatile("ds_read_b64_tr_b16 %0, %1 offset:%2" : "=&v"(r) : "v"(vb), "i"(OFF) : "memory"); return r;
}
struct VFrag { s16x4 a0, a1, a2, a3; };
template <int D> __device__ __forceinline__ void pv_reads(VFrag& f, int vb, int vc) {
    const int v = (D & 1) ? vc : vb;
    f.a0 = tr_read<v_rd_off(D >> 1, 0, 0)>(v); f.a1 = tr_read<v_rd_off(D >> 1, 0, 1)>(v); f.a2 = tr_read<v_rd_off(D >> 1, 1, 0)>(v); f.a3 = tr_read<v_rd_off(D >> 1, 1, 1)>(v);
}
#define MFA(ACC, REG, Ax, Bx) asm volatile("v_mfma_f32_16x16x32_bf16 %0, %1, %2, %0" : "+{" REG "}"(ACC) : "v"(Ax), "v"(Bx))
#define PKV(Lx, Hx) (bf16x8){Lx[0], Lx[1], Lx[2], Lx[3], Hx[0], Hx[1], Hx[2], Hx[3]}
#define PV_MMA(D, R0, R1, Fx) do { const bf16x8 lo_ = PKV(Fx.a0, Fx.a1), hi_ = PKV(Fx.a2, Fx.a3); \
    MFA(o[D][0], R0, lo_, pb00); MFA(o[D][1], R1, lo_, pb01); MFA(o[D][0], R0, hi_, pb10); MFA(o[D][1], R1, hi_, pb11); } while (0)
#define PV_WAIT12() do { asm volatile("s_waitcnt lgkmcnt(12)" ::: "memory"); SBAR(); } while (0)
#define PV_WAIT4() do { asm volatile("s_waitcnt lgkmcnt(4)" ::: "memory"); SBAR(); } while (0)
#define PV_WAIT8() do { asm volatile("s_waitcnt lgkmcnt(8)" ::: "memory"); SBAR(); } while (0)
#define PV_WAIT0() do { asm volatile("s_waitcnt lgkmcnt(0)" ::: "memory"); SBAR(); } while (0)
__device__ __forceinline__ void phase_attn(Frame& F, const Args& A, int layer) {
    const int lane = (lane_id() & 63), wid = F.wave, c16 = lane & 15, gq = lane >> 4;
    const int pr = (c16 & 3) | ((c16 & 4) << 1) | ((c16 & 8) >> 1);
    LAS unsigned char* Kl = F.lds; LAS unsigned char* Vl = F.lds + AV_OFF;
    const float lam = WSP(float, WS_CONST)[layer], Bs = WSP(float, WS_CONST)[4 + layer];
    const bf16_t* DQ = WSP(bf16_t, WS_DQ); const bf16_t* DK = WSP(bf16_t, WS_DK); const bf16_t* DV = WSP(bf16_t, WS_DV); bf16_t* OD = WSP(bf16_t, WS_ODIFF);
    for (int u = blockIdx.x; u < NH * (L / 256); u += F.G) {
        const int h = u & 7, qb = u >> 3;
        const int ld_ = opaque(lane) & 63; unsigned koff[2], voff;
#pragma unroll
        for (int i = 0; i < 2; ++i) { const int p = 2 * wid + i, row = 4 * p + (ld_ >> 4), c = (ld_ & 15) ^ (row & 15); koff[i] = (unsigned)(row * DM + c * 8) * 2u; }
        { const int s = 8 * wid + (ld_ >> 5), kg = s >> 3, cb = s & 7, rin = (ld_ & 31) >> 2, row = 8 * kg + rin;
            const int chlo = (ld_ & 3) ^ ((row >> 2) & 3); voff = (unsigned)(row * DM + cb * 32 + chlo * 8) * 2u; }
#pragma unroll 1
        for (int t = 0; t < 2; ++t) {
            int lq = lane; asm volatile("" : "+v"(lq));
            const bf16_t* Qp = DQ + (size_t)(qb * 256 + wid * 32 + (lq & 15)) * DM + (h * 2 + t) * HD + (lq >> 4) * 8;
            bf16x8 qr[2][4];
#pragma unroll
            for (int q2 = 0; q2 < 2; ++q2)
#pragma unroll
                for (int ds = 0; ds < 4; ++ds) qr[q2][ds] = *(const GAS bf16x8*)(Qp + (size_t)q2 * 16 * DM + ds * 32);
            const char* Kg = (const char*)(DK + (h * 2 + t) * HD); const char* Vg = (const char*)(DV + h * DV2);
#define ATT_DMA_K(j, b) do { const char* kb_ = Kg + (size_t)(j) * (64 * DM * 2); \
            _Pragma("unroll") for (int i_ = 0; i_ < 2; ++i_) { unsigned ko_ = koff[i_]; asm volatile("" : "+v"(ko_)); __builtin_amdgcn_global_load_lds((const unsigned*)(kb_ + ko_), (LAS unsigned*)(Kl + (b) * AK_BYTES + (2 * wid + i_) * 1024), 16, 0, 0); } } while (0)
#define ATT_DMA_V(j, b) do { const char* vb_ = Vg + (size_t)(j) * (64 * DM * 2); \
            _Pragma("unroll") for (int i_ = 0; i_ < 4; ++i_) { unsigned vo_ = voff; asm volatile("" : "+v"(vo_)); __builtin_amdgcn_global_load_lds((const unsigned*)(vb_ + 128 * i_ + vo_), (LAS unsigned*)(Vl + (b) * AV_BYTES + (4 * wid + i_) * 1024), 16, 0, 0); } } while (0)
            constexpr float C2 = 0.12751743082459868f;
#define MF16(Ax, Bx, Cx) Cx = __builtin_amdgcn_mfma_f32_16x16x32_bf16(Ax, Bx, Cx, 0, 0, 0)
#define PKB(OUT, X, Y) do { v4u w_; w_.x = cvtpk(X[0], X[1]); w_.y = cvtpk(X[2], X[3]); w_.z = cvtpk(Y[0], Y[1]); w_.w = cvtpk(Y[2], Y[3]); OUT = __builtin_bit_cast(bf16x8, w_); } while (0)
#define QK_MM(A, Q0, Q1, C) \
            "v_mfma_f32_16x16x32_bf16 %[s00], %[" A "0], %[" Q0 "], " C("s00") "\n\tv_mfma_f32_16x16x32_bf16 %[s01], %[" A "0], %[" Q1 "], " C("s01") "\n\t" \
            "v_mfma_f32_16x16x32_bf16 %[s10], %[" A "1], %[" Q0 "], " C("s10") "\n\tv_mfma_f32_16x16x32_bf16 %[s11], %[" A "1], %[" Q1 "], " C("s11") "\n\t" \
            "v_mfma_f32_16x16x32_bf16 %[s20], %[" A "2], %[" Q0 "], " C("s20") "\n\tv_mfma_f32_16x16x32_bf16 %[s21], %[" A "2], %[" Q1 "], " C("s21") "\n\t" \
            "v_mfma_f32_16x16x32_bf16 %[s30], %[" A "3], %[" Q0 "], " C("s30") "\n\tv_mfma_f32_16x16x32_bf16 %[s31], %[" A "3], %[" Q1 "], " C("s31") "\n\t"
#define QK_C0(n) "0"
#define QK_CA(n) "%[" n "]"
#define QK_RD(A, K) "ds_read_b128 %[" A "0], %[" K "]\n\tds_read_b128 %[" A "1], %[" K "] offset:4096\n\tds_read_b128 %[" A "2], %[" K "] offset:8192\n\tds_read_b128 %[" A "3], %[" K "] offset:12288\n\t"
#define ATT_QKSM(b, DMA_STMT) do { const int k0_ = (int)(uintptr_t)Kl + (b) * AK_BYTES + KSWZ(pr, 16 * gq); int kt_;        \
            f32x4 s00, s01, s10, s11, s20, s21, s30, s31; bf16x8 ka0, ka1, ka2, ka3, kc0, kc1, kc2, kc3; \
            asm volatile("s_setprio 2\n\t" \
                QK_RD("a", "k0") "v_xor_b32 %[kt], 64, %[k0]\n\t" QK_RD("c", "kt") \
                "s_waitcnt lgkmcnt(4)\n\t" QK_MM("a", "q00", "q10", QK_C0) "v_xor_b32 %[kt], 0x80, %[k0]\n\t" QK_RD("a", "kt") \
                "s_waitcnt lgkmcnt(4)\n\t" QK_MM("c", "q01", "q11", QK_CA) "v_xor_b32 %[kt], 0xc0, %[k0]\n\t" QK_RD("c", "kt") \
                "s_waitcnt lgkmcnt(4)\n\t" QK_MM("a", "q02", "q12", QK_CA) \
                "s_waitcnt lgkmcnt(0)\n\t" QK_MM("c", "q03", "q13", QK_CA) \
                "s_setprio 0\n\ts_nop 10" \
                : [s00] "=&v"(s00), [s01] "=&v"(s01), [s10] "=&v"(s10), [s11] "=&v"(s11), [s20] "=&v"(s20), [s21] "=&v"(s21), [s30] "=&v"(s30), [s31] "=&v"(s31), \
                  [a0] "=&v"(ka0), [a1] "=&v"(ka1), [a2] "=&v"(ka2), [a3] "=&v"(ka3), [c0] "=&v"(kc0), [c1] "=&v"(kc1), [c2] "=&v"(kc2), [c3] "=&v"(kc3), [kt] "=&v"(kt_) \
                : [k0] "v"(k0_), \
                  [q00] "v"(qr[0][0]), [q01] "v"(qr[0][1]), [q02] "v"(qr[0][2]), [q03] "v"(qr[0][3]), [q10] "v"(qr[1][0]), [q11] "v"(qr[1][1]), [q12] "v"(qr[1][2]), [q13] "v"(qr[1][3]) \
                : "memory"); \
            DMA_STMT; \
            float ps0 = 0.f, ps1 = 0.f; \
            _Pragma("unroll") for (int r = 0; r < 4; ++r) { \
                s00[r] = __builtin_amdgcn_exp2f(fmaf(s00[r], C2, -Bs)); s10[r] = __builtin_amdgcn_exp2f(fmaf(s10[r], C2, -Bs)); s20[r] = __builtin_amdgcn_exp2f(fmaf(s20[r], C2, -Bs)); s30[r] = __builtin_amdgcn_exp2f(fmaf(s30[r], C2, -Bs)); \
                s01[r] = __builtin_amdgcn_exp2f(fmaf(s01[r], C2, -Bs)); s11[r] = __builtin_amdgcn_exp2f(fmaf(s11[r], C2, -Bs)); s21[r] = __builtin_amdgcn_exp2f(fmaf(s21[r], C2, -Bs)); s31[r] = __builtin_amdgcn_exp2f(fmaf(s31[r], C2, -Bs)); \
                ps0 += (s00[r] + s10[r]) + (s20[r] + s30[r]); ps1 += (s01[r] + s11[r]) + (s21[r] + s31[r]); } \
            l0 += ps0; l1 += ps1; asm volatile("" : "+v"(l0), "+v"(l1));        \
            PKB(pb00, s00, s10); PKB(pb01, s01, s11); PKB(pb10, s20, s30); PKB(pb11, s21, s31); } while (0)
#define ATT_PV(b, DMA_STMT) do { const int vl_ = v_rd_base(lane_id() & 63), vb_ = (int)(uintptr_t)Vl + (b) * AV_BYTES + vl_, vc_ = (int)(uintptr_t)Vl + (b) * AV_BYTES + (vl_ ^ 32); VFrag fa_, fb_, fc_, fd_; \
            pv_reads<0>(fa_, vb_, vc_); pv_reads<1>(fb_, vb_, vc_); pv_reads<2>(fc_, vb_, vc_); \
            pv_reads<3>(fd_, vb_, vc_); PV_WAIT12(); PV_MMA(0, "v[124:127]", "v[128:131]", fa_); \
            pv_reads<4>(fa_, vb_, vc_); PV_WAIT12(); PV_MMA(1, "v[132:135]", "v[136:139]", fb_); \
            pv_reads<5>(fb_, vb_, vc_); PV_WAIT12(); PV_MMA(2, "v[140:143]", "v[144:147]", fc_); \
            pv_reads<6>(fc_, vb_, vc_); PV_WAIT12(); PV_MMA(3, "v[148:151]", "v[152:155]", fd_); \
            pv_reads<7>(fd_, vb_, vc_); PV_WAIT12(); PV_MMA(4, "v[156:159]", "v[160:163]", fa_); \
            pv_reads<8>(fa_, vb_, vc_); PV_WAIT12(); PV_MMA(5, "v[164:167]", "v[168:171]", fb_); \
            pv_reads<9>(fb_, vb_, vc_); PV_WAIT12(); PV_MMA(6, "v[172:175]", "v[176:179]", fc_); \
            pv_reads<10>(fc_, vb_, vc_); PV_WAIT12(); PV_MMA(7, "v[180:183]", "v[184:187]", fd_); \
            DMA_STMT; \
            pv_reads<11>(fd_, vb_, vc_); PV_WAIT12(); PV_MMA(8, "v[188:191]", "v[192:195]", fa_); \
            pv_reads<12>(fa_, vb_, vc_); PV_WAIT12(); PV_MMA(9, "v[196:199]", "v[200:203]", fb_); \
            pv_reads<13>(fb_, vb_, vc_); PV_WAIT12(); PV_MMA(10, "v[204:207]", "v[208:211]", fc_); \
            pv_reads<14>(fc_, vb_, vc_); PV_WAIT12(); PV_MMA(11, "v[212:215]", "v[216:219]", fd_); \
            pv_reads<15>(fd_, vb_, vc_); PV_WAIT12(); PV_MMA(12, "v[220:223]", "v[224:227]", fa_); \
            PV_WAIT8(); PV_MMA(13, "v[228:231]", "v[232:235]", fb_); \
            PV_WAIT4(); PV_MMA(14, "v[236:239]", "v[240:243]", fc_); \
            PV_WAIT0(); PV_MMA(15, "v[244:247]", "v[248:251]", fd_); } while (0)
            f32x4 o[16][2];
#pragma unroll
            for (int d = 0; d < 16; ++d)
#pragma unroll
                for (int r = 0; r < 4; ++r) { o[d][0][r] = 0.f; o[d][1][r] = 0.f; }
            float l0 = 0.f, l1 = 0.f; bf16x8 pb00, pb01, pb10, pb11;
            constexpr int NT = L / 64;
#define ATT_TSYNC() do { asm volatile("s_waitcnt vmcnt(0)" ::: "memory"); asm volatile("s_waitcnt lgkmcnt(0)" ::: "memory"); __builtin_amdgcn_s_barrier(); asm volatile("" ::: "memory"); } while (0)
            __syncthreads();
            ATT_DMA_K(0, 0); ATT_DMA_V(0, 0); VM_WAIT(); __syncthreads();
            if (wid < 4) {
                int v3 = 0;
#pragma unroll 1
                for (int j = 0; j < NT; ++j) { const int b = j & 1, vn = v3 == 2 ? 0 : v3 + 1, jn = j + 1 < NT ? j + 1 : NT - 1;
                    ATT_QKSM(b, ATT_DMA_K(jn, b ^ 1)); SBAR(); asm volatile("" ::: "memory");
                    ATT_PV(v3, ATT_DMA_V(jn, vn));
                    ATT_TSYNC(); v3 = vn; }
            } else {
                int v3 = 0;
#pragma unroll 1
                for (int j = 0; j < NT; ++j) { const int b = j & 1, vn = v3 == 2 ? 0 : v3 + 1, vp = v3 == 0 ? 2 : v3 - 1, jn = j + 1 < NT ? j + 1 : NT - 1;
                    ATT_DMA_V(jn, vn);
                    if (j > 0) ATT_PV(vp, (void)0);
                    SBAR(); asm volatile("" ::: "memory");
                    ATT_QKSM(b, ATT_DMA_K(jn, b ^ 1));
                    ATT_TSYNC(); v3 = vn; }
                ATT_PV((NT - 1) % 3, (void)0); asm volatile("s_waitcnt lgkmcnt(0)" ::: "memory");
            }
#undef ATT_TSYNC
#undef ATT_DMA_K
#undef ATT_DMA_V
#undef ATT_QKSM
#undef ATT_PV
#undef PKB
#undef MFA
#undef PKV
#undef PV_MMA
#undef MF16
#undef QK_MM
#undef QK_C0
#undef QK_CA
#undef QK_RD
            int le = lane; asm volatile("" : "+v"(le));
            const int c16e = le & 15, ge = le >> 4;
            float rl0, rl1;
            { float a0 = l0 + sw_xor<16>(l0), a1 = l1 + sw_xor<16>(l1); a0 = add_xor32(a0); a1 = add_xor32(a1); rl0 = __builtin_amdgcn_rcpf(a0); rl1 = __builtin_amdgcn_rcpf(a1); }
            GAS float* sp = (GAS float*)(WSP(float, WS_ATT) + ((size_t)(u * NWAVES + wid) * 128) * 64 + le);
            if (t == 0) {
#pragma unroll
                for (int d = 0; d < 16; ++d) {
#pragma unroll
                    for (int r = 0; r < 4; ++r) { sp[((d * 2 + 0) * 4 + r) * 64] = o[d][0][r] * rl0; sp[((d * 2 + 1) * 4 + r) * 64] = o[d][1][r] * rl1; }
                    asm volatile("" ::: "memory"); SBAR(); }
            } else {
                float ss0 = 0.f, ss1 = 0.f; const float lr0 = lam * rl0, lr1 = lam * rl1;
                float ta[8], tb[8];
#define EP_LD(T, D) _Pragma("unroll") for (int r = 0; r < 4; ++r) { T[r] = sp[(((D) * 2 + 0) * 4 + r) * 64]; T[4 + r] = sp[(((D) * 2 + 1) * 4 + r) * 64]; }
#define EP_CP(T, D) _Pragma("unroll") for (int r = 0; r < 4; ++r) { const float v0 = T[r] - lr0 * o[D][0][r]; ss0 += v0 * v0; sp[(((D) * 2 + 0) * 4 + r) * 64] = v0; const float v1 = T[4 + r] - lr1 * o[D][1][r]; ss1 += v1 * v1; sp[(((D) * 2 + 1) * 4 + r) * 64] = v1; }
                EP_LD(ta, 0);
#pragma unroll
                for (int d = 0; d < 16; d += 2) { EP_LD(tb, d + 1); SBAR(); EP_CP(ta, d); SBAR(); if (d + 2 < 16) { EP_LD(ta, d + 2); } SBAR(); EP_CP(tb, d + 1); SBAR(); }
#undef EP_CP
                ss0 += sw_xor<16>(ss0); ss1 += sw_xor<16>(ss1); ss0 = add_xor32(ss0); ss1 = add_xor32(ss1);
                ss0 = __builtin_amdgcn_rsqf(ss0 * (1.0f / DV2) + NORM_EPS); ss1 = __builtin_amdgcn_rsqf(ss1 * (1.0f / DV2) + NORM_EPS);
                GAS bf16_t* op = (GAS bf16_t*)(OD + (size_t)(qb * 256 + wid * 32 + c16e) * DM + h * DV2 + 4 * ge);
#define EP_ST(T, D) do { const unsigned w0 = pk2(T[0] * ss0, T[1] * ss0), w1 = pk2(T[2] * ss0, T[3] * ss0), w2 = pk2(T[4] * ss1, T[5] * ss1), w3 = pk2(T[6] * ss1, T[7] * ss1); \
                    *(GAS unsigned long long*)(op + (D) * 16) = (unsigned long long)w0 | ((unsigned long long)w1 << 32); *(GAS unsigned long long*)(op + (size_t)16 * DM + (D) * 16) = (unsigned long long)w2 | ((unsigned long long)w3 << 32); } while (0)
                asm volatile("s_waitcnt vmcnt(0)" ::: "memory");
                EP_LD(ta, 0);
#pragma unroll
                for (int d = 0; d < 16; d += 2) { EP_LD(tb, d + 1); SBAR(); EP_ST(ta, d); SBAR(); if (d + 2 < 16) { EP_LD(ta, d + 2); } SBAR(); EP_ST(tb, d + 1); SBAR(); }
#undef EP_LD
#undef EP_ST
            }
        }
    }
}

constexpr int PH_PER_LAYER = 8, N_PHASES = 1 + NLAYER * PH_PER_LAYER;
__global__ void __launch_bounds__(NWAVES * 64, 2) fwd(Args args) {
    extern __shared__ __attribute__((aligned(16))) unsigned char lds[];
    Frame F;
    F.lds = (LAS unsigned char*)lds; F.ws = args.ws;
    F.wave = __builtin_amdgcn_readfirstlane((int)threadIdx.x >> 6); F.lane = lane_id() & 63; F.tid = F.wave * 64 + F.lane; F.G = gridDim.x;
    volatile LAS unsigned* MISC = (volatile LAS unsigned*)(F.lds + MISC_OFF);
    if (F.tid < 32) MISC[F.tid] = 0u;
    __syncthreads();
    const int lo = args.ph_lo, hi = args.ph_hi;
    unsigned* barw = (unsigned*)(F.ws + WS_CTL) + CW_BAR;
    XcdBarrier bar; bar.bar = barw; bar.x = 0; bar.st = MISC + 8;
    if (hi - lo > 1) bar = xcd_barrier_post(barw, MISC + 8, F.wave == 0 && lane_id() == 0);
#define IN(k) (lo <= (k) && (k) < hi)
#define SEAM(k) do { if (IN(k) && IN((k) + 1)) { XcdBarrier b_ = bar; unsigned* bw_ = b_.bar; asm volatile("" : "+s"(bw_)); b_.bar = bw_; xcd_barrier(b_, F.wave == 0 && lane_id() == 0); } } while (0)
    if (IN(0)) p0_prologue(F, args);
    SEAM(0);
#pragma unroll 1
    for (int l = 0; l < NLAYER; ++l) {
        const int pb = 1 + l * PH_PER_LAYER;
        const Args& A = args;
        { unsigned char* w_ = A.ws; asm volatile("" : "+s"(w_)); F.ws = w_; int t_ = lane_id(); asm volatile("" : "+v"(t_)); F.lane = t_ & 63; F.tid = F.wave * 64 + F.lane; }
        unsigned char* wl = F.ws + WS_W + (size_t)l * W_LAYER;
        float* ssqp = WSP(float, WS_SSQP);
        if (IN(pb + 0)) {
            pg8::Gemm g{WSP(bf16_t, WS_XB), (const bf16_t*)(wl + W_IN), L, INC, DM}; pg8::StaticOrder S; S.init(L, INC, F.G, (int)blockIdx.x);
            Unit u0{4 * ((int)blockIdx.x & 7) + (((int)blockIdx.x >> 3) & 3), 0};        const float* sq = ssqp + (size_t)(2 * l) * L * 32;
            rs_panel_to_lds(F.lds, sq, u0.pm, F.wave * 64 + (lane_id() & 63));
            EpiInProj E{sq, WSP(float, WS_ROPE), F.ws, (LAS float*)(F.lds + 131072), A.in[7] + l * HD, A.in[8] + l * HD, (LAS float*)(F.lds + RS_OFF), u0.pm};
            pg8::gemm_phase<EpiInProj, pg8::StaticOrder, true, true>(F.lds, g, S, E, F.wave);
        }
        SEAM(pb + 0);
        if (IN(pb + 1)) phase_r1(F, A, l);
        SEAM(pb + 1);
        if (IN(pb + 2)) phase_r2(F, A, l);
        SEAM(pb + 2);
        if (IN(pb + 3)) phase_r3(F, A, l);
        if (IN(pb + 3)) phase_attn(F, A, l);
        SEAM(pb + 3);
        if (IN(pb + 4)) {
            { pg8::Gemm g{WSP(bf16_t, WS_URET), (const bf16_t*)(wl + W_RO), L, DM, DM}; pg8::StaticOrder S; S.init(L, DM, F.G, (int)blockIdx.x);
              const int tpm = 4 * ((int)blockIdx.x & 7) + (((int)blockIdx.x >> 3) & 3), tpn = (int)blockIdx.x >> 5;
              l2_touch_tile(F, WSP(bf16_t, WS_SGR), tpm, tpn);
              EpiGateA E{WSP(bf16_t, WS_SGR), WSP(bf16_t, WS_T1)};
              pg8::gemm_phase<EpiGateA, pg8::StaticOrder, true, true>(F.lds, g, S, E, F.wave); }
            VM_WAIT(); __syncthreads();
            { pg8::Gemm g{WSP(bf16_t, WS_ODIFF), (const bf16_t*)(wl + W_DO), L, DM, DM}; pg8::StaticOrder S; S.init(L, DM, F.G, (int)blockIdx.x);
              const int tpm = 4 * ((int)blockIdx.x & 7) + (((int)blockIdx.x >> 3) & 3), tpn = (int)blockIdx.x >> 5;
              l2_touch_tile(F, WSP(bf16_t, WS_SGD), tpm, tpn);
              EpiGateB E{WSP(bf16_t, WS_SGD), WSP(bf16_t, WS_T1), WSP(bf16_t, WS_MERGED)};
              pg8::gemm_phase<EpiGateB, pg8::StaticOrder, true, true>(F.lds, g, S, E, F.wave); }
        }
        SEAM(pb + 4);
        if (IN(pb + 5)) {
            pg8::Gemm g{WSP(bf16_t, WS_MERGED), (const bf16_t*)(wl + W_OUT), L, DM, DM}; pg8::StaticOrder S; S.init(L, DM, F.G, (int)blockIdx.x);
            EpiResid E{nullptr, WSP(bf16_t, WS_XB), ssqp + (size_t)(2 * l + 1) * L * 32};
            pg8::gemm_phase<EpiResid, pg8::StaticOrder, true, true>(F.lds, g, S, E, F.wave);
        }
        SEAM(pb + 5);
        if (IN(pb + 6)) {
            pg8::Gemm g{WSP(bf16_t, WS_XB), (const bf16_t*)(wl + W_1), L, DFF, DM}; pg8::StaticOrder S; S.init(L, DFF, F.G, (int)blockIdx.x);
            Unit u0{4 * ((int)blockIdx.x & 7) + (((int)blockIdx.x >> 3) & 3), 0};        const float* sq = ssqp + (size_t)(2 * l + 1) * L * 32;
            rs_panel_to_lds(F.lds, sq, u0.pm, F.wave * 64 + (lane_id() & 63));
            EpiMlpIn E{sq, WSP(bf16_t, WS_UMLP), (LAS float*)(F.lds + RS_OFF), u0.pm};
            pg8::gemm_phase<EpiMlpIn, pg8::StaticOrder, true, true>(F.lds, g, S, E, F.wave);
        }
        SEAM(pb + 6);
        if (IN(pb + 7)) {
            pg8::Gemm g{WSP(bf16_t, WS_UMLP), (const bf16_t*)(wl + W_2), L, DM, DFF}; pg8::StaticOrder S; S.init(L, DM, F.G, (int)blockIdx.x);
            EpiResid E{l == NLAYER - 1 ? A.out : nullptr, WSP(bf16_t, WS_XB), ssqp + (size_t)(2 * l + 2) * L * 32};
            pg8::gemm_phase<EpiResid, pg8::StaticOrder, true, true>(F.lds, g, S, E, F.wave);
            if (l + 1 < NLAYER) { VM_WAIT(); __syncthreads(); conv_layer(F, A, l + 1); }
        }
        SEAM(pb + 7);
    }
#undef IN
#undef SEAM
}


extern "C" void kernel_launch(void* const* d_in, const int* in_sizes, int n_in, void* d_out, int out_size, void* d_ws, size_t ws_size, hipStream_t stream) {
    static int grid = 0;
    if (grid == 0) {
        if (n_in != 16 || in_sizes[0] != L * DM || out_size != L * DM || ws_size < WS_END) {
            fprintf(stderr, "kernel_launch: shape mismatch: n_in %d in0 %d out %d ws %zu (need >= %zu); nothing launched\n", n_in, n_in > 0 ? in_sizes[0] : -1, out_size, ws_size, (size_t)WS_END); grid = -1; return; }
        int dev = 0, cus = 0;
        if (hipGetDevice(&dev) != hipSuccess || hipDeviceGetAttribute(&cus, hipDeviceAttributeMultiprocessorCount, dev) != hipSuccess) { fprintf(stderr, "kernel_launch: device query failed\n"); grid = -1; return; }
        if (hipFuncSetAttribute((const void*)fwd, hipFuncAttributeMaxDynamicSharedMemorySize, LDS_BYTES) != hipSuccess) { fprintf(stderr, "kernel_launch: hipFuncSetAttribute failed\n"); grid = -1; return; }
        int per_cu = 0;
        if (hipOccupancyMaxActiveBlocksPerMultiprocessor(&per_cu, (const void*)fwd, NWAVES * 64, LDS_BYTES) != hipSuccess || per_cu < 1)
            fprintf(stderr, "kernel_launch: note: occupancy query reports %d workgroups per CU\n", per_cu);
        (void)hipGetLastError();
        if (cus < 256) { fprintf(stderr, "kernel_launch: this kernel needs 256 compute units (found %d); nothing launched\n", cus); grid = -1; return; }
        grid = 256;
    }
    if (grid < 0) return;
    (void)hipMemsetAsync((char*)d_ws + WS_CTL, 0, CTL_ZERO_BYTES, stream);
    Args a{};
    for (int i = 0; i < 16; ++i) a.in[i] = (const float*)d_in[i];
    a.out = (float*)d_out; a.ws = (unsigned char*)d_ws;
    for (int j = 0; j < 64; ++j) { const float pw = (float)std::pow(10000.0, (double)((float)(2 * j) / 128.0f)); a.inv[j] = 1.0f / pw; }
    for (int l = 0; l < 4; ++l) { const double li = 0.8 - 0.6 * std::exp(-0.3 * (double)l); a.lam_init[l] = (float)li; a.om_lam_init[l] = (float)(1.0 - li); }
#if MK_ONE_LAUNCH
    a.ph_lo = 0; a.ph_hi = N_PHASES;
    hipLaunchKernelGGL(fwd, dim3(grid), dim3(NWAVES * 64), LDS_BYTES, stream, a);
#else
    for (int ph = 0; ph < N_PHASES; ++ph) { a.ph_lo = ph; a.ph_hi = ph + 1; hipLaunchKernelGGL(fwd, dim3(grid), dim3(NWAVES * 64), LDS_BYTES, stream, a); }
#endif
    const hipError_t le = hipPeekAtLastError();
    if (le != hipSuccess) fprintf(stderr, "kernel_launch: launch failed: %s\n", hipGetErrorName(le));
}
```
